# Optimizing an MI355X kernel written in HIP

```python
import jax
import jax.numpy as jnp
from jax import lax
import numpy as np

D_MODEL = 1024
BATCH = 2
SEQ = 16384
DEPTH = 4

GRID_W = 64
CTX_LEN = 256
RET_HEADS = 8
RET_DK = 64
RET_DV = 64
QK_WIDTH = RET_HEADS * RET_DK
RET_WIDTH = RET_HEADS * RET_DV
CONV_CH = 512
CONV_WIDTH = 31
MIX_WIDTH = RET_WIDTH + CONV_CH
D_FF = 4 * D_MODEL
CHUNK = 128
ROPE_BASE = 10000.0
LN_EPS = 1e-5
DEEPNORM_ALPHA = (2 * DEPTH) ** 0.25
DEEPNORM_BETA = (8 * DEPTH) ** -0.25
Q_OFF = 0
K_OFF = Q_OFF + QK_WIDTH
V_OFF = K_OFF + QK_WIDTH
G_OFF = V_OFF + RET_WIDTH
A_OFF = G_OFF + RET_WIDTH
B_OFF = A_OFF + CONV_CH
IN_WIDTH = B_OFF + CONV_CH

kernel_name = 'hybrid_retention_conformer_dit'


def layer_norm(x, w, b):
    xf = x.astype(jnp.float32)
    mu = jnp.mean(xf, axis=-1, keepdims=True)
    var = jnp.mean(jnp.square(xf - mu), axis=-1, keepdims=True)
    y = (xf - mu) * lax.rsqrt(var + LN_EPS)
    return (y * w.astype(jnp.float32) + b.astype(jnp.float32)).astype(x.dtype)


def modulate(h, shift, scale):
    return h * (1.0 + scale) + shift


def adaln(cond, w_ada, b_ada):
    return jnp.split(jax.nn.silu(cond) @ w_ada + b_ada, 6, axis=-1)


def rope_tables(n):
    rows = n // GRID_W
    row = jnp.repeat(jnp.arange(rows, dtype=jnp.float32), GRID_W)
    col = jnp.tile(jnp.arange(GRID_W, dtype=jnp.float32), rows)
    n_freq = RET_DK // 4
    inv = ROPE_BASE ** (-jnp.arange(n_freq, dtype=jnp.float32) / n_freq)
    ang = jnp.concatenate([row[:, None] * inv, col[:, None] * inv], axis=-1)
    return jnp.cos(ang), jnp.sin(ang)


def apply_rope(t, cos, sin):
    c = cos.astype(t.dtype)
    s = sin.astype(t.dtype)
    t1 = t[..., 0::2]
    t2 = t[..., 1::2]
    return jnp.stack([t1 * c - t2 * s, t1 * s + t2 * c], axis=-1).reshape(t.shape)


def split_heads(t, d):
    b, n, _ = t.shape
    return t.reshape(b, n, RET_HEADS, d).transpose(0, 2, 1, 3)


def flip_seq(t):
    return t[:, :, ::-1]


def retention_scan(q, k, v, log_gamma, s0):
    b, h, n, _ = q.shape
    dv = v.shape[-1]
    nc = n // CHUNK
    lg = log_gamma.astype(jnp.float32)[:, None]
    idx = jnp.arange(CHUNK, dtype=jnp.float32)
    diff = idx[:, None] - idx[None, :]
    intra = jnp.where(diff >= 0, jnp.exp(lg[:, :, None] * jnp.maximum(diff, 0.0)), 0.0)
    q_dec = jnp.exp(lg * (idx + 1.0))
    k_dec = jnp.exp(lg * (CHUNK - 1.0 - idx))
    c_dec = jnp.exp(lg * CHUNK)

    def chunks(t):
        return t.astype(jnp.float32).reshape(b, h, nc, CHUNK, t.shape[-1]).transpose(2, 0, 1, 3, 4)

    def step(s, qkv):
        qc, kc, vc = qkv
        scores = jnp.einsum('bhid,bhjd->bhij', qc, kc) * intra
        o = (jnp.einsum('bhij,bhjv->bhiv', scores, vc)
             + jnp.einsum('bhid,bhdv->bhiv', qc * q_dec[..., None], s))
        s = s * c_dec[..., None] + jnp.einsum('bhjd,bhjv->bhdv', kc * k_dec[..., None], vc)
        return s, o

    s_fin, o = lax.scan(step, s0.astype(jnp.float32), (chunks(q), chunks(k), chunks(v)))
    return o.transpose(1, 2, 0, 3, 4).reshape(b, h, n, dv), s_fin


def final_state(k, v, log_gamma):
    length = k.shape[2]
    lg = log_gamma.astype(jnp.float32)[:, None]
    w = jnp.exp(lg * (length - 1.0 - jnp.arange(length, dtype=jnp.float32)))
    return jnp.einsum('bhjd,bhjv->bhdv', k.astype(jnp.float32) * w[..., None], v.astype(jnp.float32))


def retention_readout(o, g, gn_w, gn_b):
    mu = jnp.mean(o, axis=-1, keepdims=True)
    var = jnp.mean(jnp.square(o - mu), axis=-1, keepdims=True)
    on = (o - mu) * lax.rsqrt(var + LN_EPS)
    b, h, n, dv = on.shape
    on = on.transpose(0, 2, 1, 3).reshape(b, n, h * dv)
    on = (on * gn_w.astype(jnp.float32) + gn_b.astype(jnp.float32)).astype(g.dtype)
    return jax.nn.silu(g) * on


def conformer_conv(a, gate, conv_w, conv_b, ln_w, ln_b):
    u = a * jax.nn.sigmoid(gate)
    u = lax.conv_general_dilated(
        u, conv_w[:, None, :], window_strides=(1,),
        padding=[(CONV_WIDTH // 2, CONV_WIDTH // 2)],
        dimension_numbers=('NWC', 'WIO', 'NWC'),
        feature_group_count=CONV_CH) + conv_b
    return jax.nn.silu(layer_norm(u, ln_w, ln_b))


def mixer_output(o_ret, p, gn_w, gn_b, conv_w, conv_b, cln_w, cln_b, w_out):
    ret = retention_readout(o_ret, p[..., G_OFF:A_OFF], gn_w, gn_b)
    conv = conformer_conv(p[..., A_OFF:B_OFF], p[..., B_OFF:IN_WIDTH], conv_w, conv_b, cln_w, cln_b)
    return jnp.concatenate([ret, conv], axis=-1) @ w_out


def mlp_sublayer(h, shift, scale, gate, w1, w2, ln_w, ln_b):
    y = jnp.square(jax.nn.relu(modulate(h, shift, scale) @ w1)) @ w2
    return layer_norm(DEEPNORM_ALPHA * h + gate * y, ln_w, ln_b)


def setup_inputs(seed: int = 0) -> dict:
    key = jax.random.key(seed)
    ks = jax.random.split(key, 22)
    f32 = jnp.float32

    def nrm(k, shape, s):
        return jax.random.normal(k, shape, f32) * s

    base_rate = jnp.log(-jnp.log1p(-(2.0 ** (-5.0 - jnp.arange(RET_HEADS, dtype=f32)))))
    v_scale = jnp.ones((IN_WIDTH,), f32).at[V_OFF:G_OFF].set(DEEPNORM_BETA)
    return {
        'x': nrm(ks[0], (BATCH, SEQ, D_MODEL), 1.0),
        'c': nrm(ks[1], (BATCH, D_MODEL), 1.0),
        'ctx': nrm(ks[2], (BATCH, CTX_LEN, D_MODEL), 1.0),
        'c_ctx': nrm(ks[3], (D_MODEL,), 1.0),
        'w_ada': nrm(ks[4], (DEPTH, D_MODEL, 6 * D_MODEL), 0.5 * D_MODEL ** -0.5),
        'b_ada': nrm(ks[5], (DEPTH, 6 * D_MODEL), 0.01),
        'w_in': nrm(ks[6], (DEPTH, D_MODEL, IN_WIDTH), D_MODEL ** -0.5) * v_scale,
        'ret_log_rate_fwd': base_rate + nrm(ks[7], (DEPTH, RET_HEADS), 0.1),
        'ret_log_rate_bwd': base_rate + nrm(ks[8], (DEPTH, RET_HEADS), 0.1),
        'ret_gn_w': 1.0 + nrm(ks[9], (DEPTH, RET_WIDTH), 0.02),
        'ret_gn_b': nrm(ks[10], (DEPTH, RET_WIDTH), 0.02),
        'conv_w': nrm(ks[11], (DEPTH, CONV_WIDTH, CONV_CH), CONV_WIDTH ** -0.5),
        'conv_b': nrm(ks[12], (DEPTH, CONV_CH), 0.02),
        'conv_ln_w': 1.0 + nrm(ks[13], (DEPTH, CONV_CH), 0.02),
        'conv_ln_b': nrm(ks[14], (DEPTH, CONV_CH), 0.02),
        'w_out': nrm(ks[15], (DEPTH, MIX_WIDTH, D_MODEL), DEEPNORM_BETA * MIX_WIDTH ** -0.5),
        'ln1_w': 1.0 + nrm(ks[16], (DEPTH, D_MODEL), 0.02),
        'ln1_b': nrm(ks[17], (DEPTH, D_MODEL), 0.02),
        'w_ff1': nrm(ks[18], (DEPTH, D_MODEL, D_FF), D_MODEL ** -0.5),
        'w_ff2': nrm(ks[19], (DEPTH, D_FF, D_MODEL), DEEPNORM_BETA * D_FF ** -0.5),
        'ln2_w': 1.0 + nrm(ks[20], (DEPTH, D_MODEL), 0.02),
        'ln2_b': nrm(ks[21], (DEPTH, D_MODEL), 0.02),
    }


def reference(x, c, ctx, c_ctx, w_ada, b_ada, w_in, ret_log_rate_fwd, ret_log_rate_bwd,
              ret_gn_w, ret_gn_b, conv_w, conv_b, conv_ln_w, conv_ln_b, w_out,
              ln1_w, ln1_b, w_ff1, w_ff2, ln2_w, ln2_b):
    n = x.shape[1]
    cos, sin = rope_tables(n)
    zero_state = jnp.zeros((x.shape[0], RET_HEADS, RET_DK, RET_DV), jnp.float32)

    for l in range(DEPTH):
        last = l == DEPTH - 1
        sh1, sc1, g1, sh2, sc2, g2 = [t[:, None, :] for t in adaln(c, w_ada[l], b_ada[l])]
        csh1, csc1, cg1, csh2, csc2, cg2 = adaln(c_ctx, w_ada[l], b_ada[l])
        lg_f = -jnp.exp(ret_log_rate_fwd[l])
        lg_b = -jnp.exp(ret_log_rate_bwd[l])

        hc = modulate(ctx, csh1, csc1)
        if last:
            pkv = hc @ w_in[l][:, K_OFF:G_OFF]
            kc = split_heads(pkv[..., :QK_WIDTH], RET_DK)
            vc = split_heads(pkv[..., QK_WIDTH:], RET_DV)
            s_f = final_state(kc, vc, lg_f)
            s_b = final_state(flip_seq(kc), flip_seq(vc), lg_b)
        else:
            pc = hc @ w_in[l]
            qc = split_heads(pc[..., Q_OFF:K_OFF], RET_DK)
            kc = split_heads(pc[..., K_OFF:V_OFF], RET_DK) * (RET_DK ** -0.5)
            vc = split_heads(pc[..., V_OFF:G_OFF], RET_DV)
            oc_f, s_f = retention_scan(qc, kc, vc, lg_f, zero_state)
            oc_b, s_b = retention_scan(flip_seq(qc), flip_seq(kc), flip_seq(vc), lg_b, zero_state)
            mix_c = mixer_output(oc_f + flip_seq(oc_b), pc, ret_gn_w[l], ret_gn_b[l],
                                 conv_w[l], conv_b[l], conv_ln_w[l], conv_ln_b[l], w_out[l])

        p = modulate(x, sh1, sc1) @ w_in[l]
        q = apply_rope(split_heads(p[..., Q_OFF:K_OFF], RET_DK), cos, sin)
        k = apply_rope(split_heads(p[..., K_OFF:V_OFF], RET_DK), cos, sin) * (RET_DK ** -0.5)
        v = split_heads(p[..., V_OFF:G_OFF], RET_DV)
        o_f, _ = retention_scan(q, k, v, lg_f, s_f)
        o_b, _ = retention_scan(flip_seq(q), flip_seq(k), flip_seq(v), lg_b, s_b)
        mix_x = mixer_output(o_f + flip_seq(o_b), p, ret_gn_w[l], ret_gn_b[l],
                             conv_w[l], conv_b[l], conv_ln_w[l], conv_ln_b[l], w_out[l])
        x = layer_norm(DEEPNORM_ALPHA * x + g1 * mix_x, ln1_w[l], ln1_b[l])
        x = mlp_sublayer(x, sh2, sc2, g2, w_ff1[l], w_ff2[l], ln2_w[l], ln2_b[l])

        if not last:
            ctx = layer_norm(DEEPNORM_ALPHA * ctx + cg1 * mix_c, ln1_w[l], ln1_b[l])
            ctx = mlp_sublayer(ctx, csh2, csc2, cg2, w_ff1[l], w_ff2[l], ln2_w[l], ln2_b[l])

    return x
```

```cpp
#include <hip/hip_runtime.h>
#include <hip/hip_cooperative_groups.h>
#include <cstdio>
namespace cg = cooperative_groups;

#define LAS __attribute__((address_space(3)))
typedef unsigned short bf16_t;
typedef short bf16x8 __attribute__((ext_vector_type(8)));
typedef float f32x4 __attribute__((ext_vector_type(4)));
typedef unsigned u32x4 __attribute__((ext_vector_type(4)));
typedef unsigned u32x2 __attribute__((ext_vector_type(2)));

constexpr int DM = 1024, NLAT = 32768, MTOT = 33280, SEQL = 16384, DEPTH = 4;
constexpr int INW = 3072, DFF = 4096, NRC = 260  ;
constexpr float LN_EPS = 1e-5f;
constexpr float ALPHA = 1.681792830507429f;
constexpr float LOG2E = 1.4426950408889634f;

constexpr size_t OFF_WIN = 0;
constexpr size_t OFF_WOUT = OFF_WIN + (size_t)INW * DM * 2;
constexpr size_t OFF_WFF1 = OFF_WOUT + (size_t)DM * DM * 2;
constexpr size_t OFF_WFF2 = OFF_WFF1 + (size_t)DFF * DM * 2;
constexpr size_t OFF_ADA = OFF_WFF2 + (size_t)DFF * DM * 2;
constexpr size_t OFF_ROPE = OFF_ADA + (size_t)DEPTH * 3 * 6144 * 4;
constexpr size_t OFF_X = OFF_ROPE + 256 * 16 * 8;
constexpr size_t OFF_H = OFF_X + (size_t)MTOT * DM * 4;
constexpr size_t OFF_R = OFF_H + (size_t)MTOT * DM * 2;
constexpr size_t R_QKVG = 0;
constexpr size_t R_U = R_QKVG + (size_t)MTOT * 2048 * 2;
constexpr size_t R_KV = R_U + (size_t)MTOT * 512 * 2;
constexpr size_t R_ST = R_KV + (size_t)2 * NRC * 8 * 4096 * 4;
constexpr size_t R_END = R_ST + (size_t)2 * NRC * 8 * 4096 * 2;
constexpr size_t HM_BYTES = (size_t)MTOT * DFF * 2;
constexpr size_t WS_END = OFF_R + (R_END > HM_BYTES ? R_END : HM_BYTES);
constexpr int LDS_BYTES = 131072;

struct Params {
    const float *x, *c, *ctx, *c_ctx, *w_ada, *b_ada, *w_in, *rate_f, *rate_b, *gn_w, *gn_b, *conv_w, *conv_b, *cln_w, *cln_b, *w_out,
        *ln1_w, *ln1_b, *w_ff1, *w_ff2, *ln2_w, *ln2_b;
    float* out;
    unsigned char* ws;
};

__device__ __forceinline__ unsigned f2bf(float f) { unsigned u = __builtin_bit_cast(unsigned, f); return (u + 0x7fffu + ((u >> 16) & 1u)) >> 16; }
__device__ __forceinline__ float bf2f(unsigned b) { return __builtin_bit_cast(float, b << 16); }
__device__ __forceinline__ float bflo(unsigned u) { return __builtin_bit_cast(float, u << 16); }
__device__ __forceinline__ float bfhi(unsigned u) { return __builtin_bit_cast(float, u & 0xffff0000u); }
__device__ __forceinline__ unsigned cvt_pk_bf16(float lo, float hi) { unsigned r; asm volatile("v_cvt_pk_bf16_f32 %0, %1, %2" : "=v"(r) : "v"(lo), "v"(hi)); return r; }
__device__ __forceinline__ int launder_tid() { int t = threadIdx.x; asm volatile("" : "+v"(t)); return t; }
__device__ __forceinline__ int launder_s(int v) { asm volatile("" : "+s"(v)); return v; }
template <class T> __device__ __forceinline__ T* launder_p(T* q) { asm volatile("" : "+s"(q)); return q; }
__device__ __forceinline__ float sigmoidf_(float v) { return 1.0f / (1.0f + __expf(-v)); }

namespace pg8 {
constexpr int BM = 256, BK = 64, HALF = 128, HTB = HALF * BK * 2, STAGE_BYTES = 8 * HTB, NXCD = 8, WGM = 8;
__host__ __device__ __forceinline__ int lds_byte(int r, int c) { const int st = (r >> 4) * 2 + (c >> 5), rr = r & 15, cc = c & 31, ob = rr * 64 + cc * 2; return st * 1024 + (ob ^ (((ob >> 9) & 1) << 5)); }
__host__ __device__ __forceinline__ void stage_rc(int b, int& R, int& C) { const int st = b / 1024, sb = b % 1024, swz = sb ^ (((sb >> 9) & 1) << 5); R = (st >> 1) * 16 + swz / 64; C = (st & 1) * 32 + (swz % 64) / 2; }
__host__ __device__ __forceinline__ int perm32(int rho) { const int n = rho >> 4, i = rho & 15; return 8 * (i >> 2) + 4 * n + (i & 3); }

struct Unit { int pm, pn; };
struct Gemm { const bf16_t* A; const bf16_t* Bt; int M, N, K; };

struct StaticOrder {
    int nM, nN, nwg, G, c;
    __device__ void init(int M, int N, int G_, int c_) { nM = M / BM; nN = N / BM; nwg = nM * nN; G = G_; c = c_; }
    __device__ bool next(int i, Unit& u) const {
        const long L = (long)i * G + c; if (L >= nwg) return false;
        int wgid = (int)L; { const int q = nwg / NXCD, r = nwg % NXCD, xcd = wgid % NXCD, off = wgid / NXCD; wgid = (xcd < r ? xcd * (q + 1) : r * (q + 1) + (xcd - r) * q) + off; }
        const int nig = WGM * nN, gid = wgid / nig, fm = gid * WGM, gsz = (nM - fm) < WGM ? (nM - fm) : WGM;
        u.pm = fm + ((wgid % nig) % gsz); u.pn = (wgid % nig) / gsz; return true;
    }
};

template <class Epi>
__device__ __forceinline__ void gemm_phase(LAS unsigned char* lds, const Gemm g, const StaticOrder& S, const Epi& E) {
    const int tid = launder_tid(), wid = __builtin_amdgcn_readfirstlane(tid >> 6), lane = tid & 63, wr = wid >> 2, wc = wid & 3, fr = lane & 15, fq = lane >> 4;
    const int K = g.K, nt = K / BK;
    unsigned voffA[2], voffB[2];
#pragma unroll
    for (int i = 0; i < 2; ++i) { int R, C; stage_rc(tid * 16 + i * 8192, R, C); const int Rb = Epi::PERM ? ((R & ~31) + perm32(R & 31)) : R;
        voffA[i] = (unsigned)(R * K + C) * 2u; voffB[i] = (unsigned)(Rb * K + C) * 2u; }
    const size_t kstep = (size_t)(BK * 2);
    const size_t hstep = (size_t)HALF * K * 2;
    const size_t tstep = 2 * hstep;
    const unsigned ldsw = (unsigned)wid * 1024u;
    const int aoff = lds_byte(wr * 64 + fr, fq * 8), boff = lds_byte(wc * 32 + fr, fq * 8);
#define PG8_SA(b, h) (((b) * 2 + (h)) * HTB)
#define PG8_SB(b, h) ((4 + (b) * 2 + (h)) * HTB)
#define PG8_STAGE(bufoff, gbase, voff) do { _Pragma("unroll") for (int _i = 0; _i < 2; ++_i) \
        __builtin_amdgcn_global_load_lds((const unsigned*)((const char*)(gbase) + (voff)[_i]), (LAS unsigned*)(lds + (bufoff) + ldsw + _i * 8192), 16, 0, 0); } while (0)
#define PG8_LDA(dst, b, h) do { _Pragma("unroll") for (int m = 0; m < 4; ++m) _Pragma("unroll") for (int k = 0; k < 2; ++k) dst[m][k] = *(const LAS bf16x8*)(lds + PG8_SA(b, h) + aoff + m * 2048 + k * 1024); } while (0)
#define PG8_LDB(dst, b, h) do { _Pragma("unroll") for (int n = 0; n < 2; ++n) _Pragma("unroll") for (int k = 0; k < 2; ++k) dst[n][k] = *(const LAS bf16x8*)(lds + PG8_SB(b, h) + boff + n * 2048 + k * 1024); } while (0)
#define PG8_MMA(ai, bj, At, Bt) do { __builtin_amdgcn_s_setprio(1); _Pragma("unroll") for (int m = 0; m < 4; ++m) _Pragma("unroll") for (int n = 0; n < 2; ++n) _Pragma("unroll") for (int k = 0; k < 2; ++k) \
        acc[ai][bj][m][n] = __builtin_amdgcn_mfma_f32_16x16x32_bf16(Bt[n][k], At[m][k], acc[ai][bj][m][n], 0, 0, 0); __builtin_amdgcn_s_setprio(0); } while (0)
#define PG8_WAIT_V(n) asm volatile("s_waitcnt vmcnt(" #n ")" ::: "memory")
#define PG8_WAIT_L(n) asm volatile("s_waitcnt lgkmcnt(" #n ")" ::: "memory")
#define PG8_BAR __builtin_amdgcn_s_barrier()
#define PG8_SCHED __builtin_amdgcn_sched_barrier(0)
    Unit cur, nxt; int ui = 0;
    if (!S.next(0, cur)) return;
    f32x4 acc[2][2][4][2];
#pragma unroll
    for (int a = 0; a < 2; ++a)
#pragma unroll
        for (int b = 0; b < 2; ++b)
#pragma unroll
            for (int m = 0; m < 4; ++m)
#pragma unroll
                for (int n = 0; n < 2; ++n) acc[a][b][m][n] = (f32x4){0.f, 0.f, 0.f, 0.f};
    bf16x8 At[4][2], B0[2][2], B1[2][2];
    const char* cA = (const char*)g.A + (size_t)cur.pm * tstep; const char* cB = (const char*)g.Bt + (size_t)cur.pn * tstep;
    PG8_STAGE(PG8_SB(0, 0), cB, voffB); PG8_STAGE(PG8_SB(0, 1), cB + hstep, voffB); PG8_STAGE(PG8_SA(0, 0), cA, voffA); PG8_STAGE(PG8_SA(0, 1), cA + hstep, voffA);
    if (wr == 1) PG8_BAR;
    PG8_WAIT_V(2); PG8_BAR;
    PG8_STAGE(PG8_SB(1, 0), cB + kstep, voffB); PG8_STAGE(PG8_SA(1, 0), cA + kstep, voffA); PG8_STAGE(PG8_SB(1, 1), cB + hstep + kstep, voffB);
    PG8_WAIT_V(6); PG8_BAR;
    for (;;) {
        const bool has_next = S.next(ui + 1, nxt);
        const char* nA = has_next ? (const char*)g.A + (size_t)nxt.pm * tstep : cA; const char* nB = has_next ? (const char*)g.Bt + (size_t)nxt.pn * tstep : cB;
        for (int t = 0; t < nt; t += 2) {
            const bool last = (t == nt - 2);
            const char* a1 = cA + (size_t)(t + 1) * kstep;
            const char* a2 = last ? nA : cA + (size_t)(t + 2) * kstep; const char* b2 = last ? nB : cB + (size_t)(t + 2) * kstep;
            const char* a3 = a2 + kstep; const char* b3 = b2 + kstep;
            PG8_LDB(B0, 0, 0); PG8_LDB(B1, 0, 1); PG8_SCHED; PG8_LDA(At, 0, 0); PG8_STAGE(PG8_SA(1, 1), a1 + hstep, voffA);
            PG8_WAIT_V(8); PG8_WAIT_L(0); PG8_BAR; PG8_MMA(0, 0, At, B0); PG8_MMA(0, 1, At, B1); PG8_BAR; PG8_SCHED;
            PG8_LDA(At, 0, 1); PG8_STAGE(PG8_SB(0, 0), b2, voffB); PG8_STAGE(PG8_SB(0, 1), b2 + hstep, voffB); PG8_STAGE(PG8_SA(0, 0), a2, voffA);
            PG8_WAIT_V(8); PG8_WAIT_L(0); PG8_BAR; PG8_MMA(1, 0, At, B0); PG8_MMA(1, 1, At, B1); PG8_BAR; PG8_SCHED;
            PG8_LDB(B0, 1, 0); PG8_LDB(B1, 1, 1); PG8_SCHED; PG8_LDA(At, 1, 0); PG8_STAGE(PG8_SA(0, 1), a2 + hstep, voffA);
            PG8_WAIT_V(8); PG8_WAIT_L(0); PG8_BAR; PG8_MMA(0, 0, At, B0); PG8_MMA(0, 1, At, B1); PG8_BAR; PG8_SCHED;
            PG8_LDA(At, 1, 1); PG8_STAGE(PG8_SB(1, 0), b3, voffB); PG8_STAGE(PG8_SB(1, 1), b3 + hstep, voffB); PG8_STAGE(PG8_SA(1, 0), a3, voffA);
            PG8_WAIT_V(8); PG8_WAIT_L(0); PG8_BAR; PG8_MMA(1, 0, At, B0); PG8_MMA(1, 1, At, B1); PG8_BAR; PG8_SCHED;
        }
        if (wr == 0) PG8_BAR;
        E(acc, cur, wr, wc, fr, fq);
        if (!has_next) break;
#pragma unroll
        for (int a = 0; a < 2; ++a)
#pragma unroll
            for (int b = 0; b < 2; ++b)
#pragma unroll
                for (int m = 0; m < 4; ++m)
#pragma unroll
                    for (int n = 0; n < 2; ++n) acc[a][b][m][n] = (f32x4){0.f, 0.f, 0.f, 0.f};
        cur = nxt; cA = nA; cB = nB; ++ui;
        if (wr == 1) PG8_BAR;
    }
    PG8_WAIT_V(0);
    PG8_BAR;
#undef PG8_SA
#undef PG8_SB
#undef PG8_STAGE
#undef PG8_LDA
#undef PG8_LDB
#undef PG8_MMA
#undef PG8_WAIT_V
#undef PG8_WAIT_L
#undef PG8_BAR
#undef PG8_SCHED
}
}

struct EpiInProj {
    static constexpr bool PERM = true;
    bf16_t* QKVG; bf16_t* U; const float* rope; int last;
    __device__ __forceinline__ void operator()(const f32x4 (&acc)[2][2][4][2], const pg8::Unit& u, int wr, int wc, int fr, int fq) const {
        const int row0 = u.pm * 256 + wr * 64 + fr;
        const bool is_ctx = u.pm >= 128;
        if (u.pn < 8) {
            const int colb = u.pn * 256 + wc * 32 + 8 * fq;
            const bool do_rope = (u.pn < 4) && !is_ctx;
            const float kscale = (u.pn >= 2 && u.pn < 4 && !(is_ctx && last)) ? 0.125f : 1.0f;
#pragma unroll
            for (int ai = 0; ai < 2; ++ai)
#pragma unroll
                for (int m = 0; m < 4; ++m) {
                    const int row = row0 + ai * 128 + m * 16;
                    f32x4 cs0 = {1.f, 0.f, 1.f, 0.f}, cs1 = {1.f, 0.f, 1.f, 0.f};
                    if (do_rope) { const int pos = (wc & 1) ? (row & 63) : ((row & (SEQL - 1)) >> 6);
                        const f32x4* rp = (const f32x4*)(rope + (size_t)(pos * 16 + 4 * fq) * 2); cs0 = rp[0]; cs1 = rp[1]; }
                    bf16_t* rowp = QKVG + (size_t)row * 2048 + colb;
#pragma unroll
                    for (int bj = 0; bj < 2; ++bj) {
                        f32x4 v0 = acc[ai][bj][m][0], v1 = acc[ai][bj][m][1];
                        if (do_rope) {
                            f32x4 w0, w1;
                            w0[0] = v0[0] * cs0[0] - v0[1] * cs0[1]; w0[1] = v0[0] * cs0[1] + v0[1] * cs0[0];
                            w0[2] = v0[2] * cs0[2] - v0[3] * cs0[3]; w0[3] = v0[2] * cs0[3] + v0[3] * cs0[2];
                            w1[0] = v1[0] * cs1[0] - v1[1] * cs1[1]; w1[1] = v1[0] * cs1[1] + v1[1] * cs1[0];
                            w1[2] = v1[2] * cs1[2] - v1[3] * cs1[3]; w1[3] = v1[2] * cs1[3] + v1[3] * cs1[2];
                            v0 = w0; v1 = w1;
                        }
                        v0 *= kscale; v1 *= kscale;
                        u32x4 w; w.x = cvt_pk_bf16(v0[0], v0[1]); w.y = cvt_pk_bf16(v0[2], v0[3]); w.z = cvt_pk_bf16(v1[0], v1[1]); w.w = cvt_pk_bf16(v1[2], v1[3]);
                        *(u32x4*)(rowp + bj * 128) = w;
                    }
                }
        } else {
            const int colb = (u.pn - 8) * 128 + wc * 32 + 8 * fq;
#pragma unroll
            for (int ai = 0; ai < 2; ++ai)
#pragma unroll
                for (int m = 0; m < 4; ++m) {
                    const int row = row0 + ai * 128 + m * 16;
                    f32x4 a0 = acc[ai][0][m][0], a1 = acc[ai][0][m][1], g0 = acc[ai][1][m][0], g1 = acc[ai][1][m][1];
#pragma unroll
                    for (int j = 0; j < 4; ++j) { a0[j] *= sigmoidf_(g0[j]); a1[j] *= sigmoidf_(g1[j]); }
                    u32x4 w; w.x = cvt_pk_bf16(a0[0], a0[1]); w.y = cvt_pk_bf16(a0[2], a0[3]); w.z = cvt_pk_bf16(a1[0], a1[1]); w.w = cvt_pk_bf16(a1[2], a1[3]);
                    *(u32x4*)(U + (size_t)row * 512 + colb) = w;
                }
        }
    }
};
struct EpiRes {
    static constexpr bool PERM = false;
    float* X; const float* gate;
    __device__ __forceinline__ void operator()(const f32x4 (&acc)[2][2][4][2], const pg8::Unit& u, int wr, int wc, int fr, int fq) const {
        const int row0 = u.pm * 256 + wr * 64 + fr, col0 = u.pn * 256 + wc * 32 + 4 * fq;
        const int cond = u.pm < 64 ? 0 : (u.pm < 128 ? 1 : 2);
        const float* gp = gate + cond * 6144 + col0;
        f32x4 gv[2][2];
#pragma unroll
        for (int bj = 0; bj < 2; ++bj)
#pragma unroll
            for (int n = 0; n < 2; ++n) gv[bj][n] = *(const f32x4*)(gp + bj * 128 + n * 16);
#pragma unroll
        for (int ai = 0; ai < 2; ++ai)
#pragma unroll
            for (int m = 0; m < 4; ++m) { float* rowp = X + (size_t)(row0 + ai * 128 + m * 16) * DM + col0;
#pragma unroll
                for (int bj = 0; bj < 2; ++bj)
#pragma unroll
                    for (int n = 0; n < 2; ++n) { f32x4 xv = *(const f32x4*)(rowp + bj * 128 + n * 16); xv = xv * ALPHA + gv[bj][n] * acc[ai][bj][m][n]; *(f32x4*)(rowp + bj * 128 + n * 16) = xv; } }
    }
};
struct EpiFF1 {
    static constexpr bool PERM = true;
    bf16_t* O;
    __device__ __forceinline__ void operator()(const f32x4 (&acc)[2][2][4][2], const pg8::Unit& u, int wr, int wc, int fr, int fq) const {
        const int row0 = u.pm * 256 + wr * 64 + fr, col0 = u.pn * 256 + wc * 32 + 8 * fq;
#pragma unroll
        for (int ai = 0; ai < 2; ++ai)
#pragma unroll
            for (int m = 0; m < 4; ++m) { bf16_t* rowp = O + (size_t)(row0 + ai * 128 + m * 16) * DFF + col0;
#pragma unroll
                for (int bj = 0; bj < 2; ++bj) { f32x4 v0 = acc[ai][bj][m][0], v1 = acc[ai][bj][m][1];
#pragma unroll
                    for (int j = 0; j < 4; ++j) { float a = fmaxf(v0[j], 0.f), b = fmaxf(v1[j], 0.f); v0[j] = a * a; v1[j] = b * b; }
                    u32x4 w; w.x = cvt_pk_bf16(v0[0], v0[1]); w.y = cvt_pk_bf16(v0[2], v0[3]); w.z = cvt_pk_bf16(v1[0], v1[1]); w.w = cvt_pk_bf16(v1[2], v1[3]);
                    *(u32x4*)(rowp + bj * 128) = w; } }
    }
};

__device__ __forceinline__ void convert_weights(const Params& p, int l, unsigned char* lds_g) {
    const int bid_ = launder_s(blockIdx.x);
    float* ls = (float*)lds_g;
    const int tid = launder_tid();
    for (int t = bid_; t < 3072; t += gridDim.x) {
        const float* W; bf16_t* Wt; int K, N, tt;
        if (t < 768) { W = p.w_in + (size_t)l * DM * INW; Wt = (bf16_t*)(p.ws + OFF_WIN); K = DM; N = INW; tt = t; }
        else if (t < 1024) { W = p.w_out + (size_t)l * DM * DM; Wt = (bf16_t*)(p.ws + OFF_WOUT); K = DM; N = DM; tt = t - 768; }
        else if (t < 2048) { W = p.w_ff1 + (size_t)l * DM * DFF; Wt = (bf16_t*)(p.ws + OFF_WFF1); K = DM; N = DFF; tt = t - 1024; }
        else { W = p.w_ff2 + (size_t)l * DFF * DM; Wt = (bf16_t*)(p.ws + OFF_WFF2); K = DFF; N = DM; tt = t - 2048; }
        const int ntn = N / 64, k0 = (tt / ntn) * 64, n0 = (tt % ntn) * 64;
#pragma unroll
        for (int i = 0; i < 8; ++i) { const int k = (tid >> 6) + 8 * i, n = tid & 63; ls[k * 65 + n] = W[(size_t)(k0 + k) * N + n0 + n]; }
        __syncthreads();
        { const int n = tid >> 3, kk = (tid & 7) * 8;
          float v[8];
#pragma unroll
          for (int j = 0; j < 8; ++j) v[j] = ls[(kk + j) * 65 + n];
          int nn = n0 + n;
          if (t < 768 && nn >= 2048) { const int isb = nn >= 2560; const int cc = nn - (isb ? 2560 : 2048); nn = 2048 + 256 * (cc >> 7) + 128 * isb + (cc & 127); }
          u32x4 w; w.x = cvt_pk_bf16(v[0], v[1]); w.y = cvt_pk_bf16(v[2], v[3]); w.z = cvt_pk_bf16(v[4], v[5]); w.w = cvt_pk_bf16(v[6], v[7]);
          *(u32x4*)(Wt + (size_t)nn * K + k0 + kk) = w; }
        __syncthreads();
    }
}

__device__ __forceinline__ void phase_adaln_rope(const Params& p, unsigned char* lds_g) {
    const int bid_ = launder_s(blockIdx.x);
    float* sc = (float*)lds_g;
    float* red = sc + 3 * 1024;
    const int tid = launder_tid(), wave = tid >> 6, lane = tid & 63;
    for (int e = bid_ * 512 + tid; e < 256 * 16; e += gridDim.x * 512) {
        const int pos = e >> 4, f = e & 15;
        const float inv = powf(10000.0f, -(float)f / 16.0f);
        const float angf = (float)pos * inv;
        double a = (double)angf;
        const double twopi = 6.283185307179586476925;
        a -= twopi * rint(a / twopi);
        const double a2 = a * a;
        double sn = 0.0, cn = 0.0, ts = a, tc = 1.0;
        for (int i = 0; i < 16; ++i) { cn += tc; sn += ts; tc = -tc * a2 / (double)((2 * i + 1) * (2 * i + 2)); ts = -ts * a2 / (double)((2 * i + 2) * (2 * i + 3)); }
        float* rp = (float*)(p.ws + OFF_ROPE);
        rp[2 * e] = (float)cn; rp[2 * e + 1] = (float)sn;
    }
    for (int i = tid; i < 3072; i += 512) { const float v = i < 2048 ? p.c[i] : p.c_ctx[i - 2048]; sc[i] = v * sigmoidf_(v); }
    __syncthreads();
    float* ADA = (float*)(p.ws + OFF_ADA);
    for (int item = bid_; item < DEPTH * 96; item += gridDim.x) {
        const int l = item / 96, n0 = (item % 96) * 64;
        const float* W = p.w_ada + (size_t)l * DM * 6144 + n0 + lane;
        float a0 = 0.f, a1 = 0.f, a2 = 0.f;
        const int kb = wave * 128;
#pragma unroll 8
        for (int k = 0; k < 128; ++k) { const float w = W[(size_t)(kb + k) * 6144]; a0 += sc[kb + k] * w; a1 += sc[1024 + kb + k] * w; a2 += sc[2048 + kb + k] * w; }
        red[(wave * 3 + 0) * 64 + lane] = a0; red[(wave * 3 + 1) * 64 + lane] = a1; red[(wave * 3 + 2) * 64 + lane] = a2;
        __syncthreads();
        if (tid < 192) { const int j = tid >> 6; float s = 0.f;
#pragma unroll
            for (int w = 0; w < 8; ++w) s += red[(w * 3 + j) * 64 + lane];
            ADA[(size_t)(l * 3 + j) * 6144 + n0 + lane] = s + p.b_ada[l * 6144 + n0 + lane]; }
        __syncthreads();
    }
}

__device__ __forceinline__ void row_pass(const Params& p, int nrows, const float* lnw, const float* lnb, const float* ada_l, int sh_idx, bool init, bool final_) {
    const int tid = launder_tid(), wave = tid >> 6, lane = tid & 63;
    float* X = (float*)(p.ws + OFF_X); bf16_t* H = (bf16_t*)(p.ws + OFF_H);
    f32x4 w4[4], b4[4];
    if (!init) {
#pragma unroll
        for (int i = 0; i < 4; ++i) { w4[i] = ((const f32x4*)lnw)[lane + 64 * i]; b4[i] = ((const f32x4*)lnb)[lane + 64 * i]; }
    }
    for (int row = launder_s(blockIdx.x) * 8 + wave; row < nrows; row += gridDim.x * 8) {
        const int cond = row < SEQL ? 0 : (row < NLAT ? 1 : 2);
        const float* src = init ? (row < NLAT ? p.x + (size_t)row * DM : p.ctx + (size_t)(row - NLAT) * DM) : X + (size_t)row * DM;
        f32x4 v[4];
#pragma unroll
        for (int i = 0; i < 4; ++i) v[i] = ((const f32x4*)src)[lane + 64 * i];
        if (!init) {
            float s = 0.f;
#pragma unroll
            for (int i = 0; i < 4; ++i) s += v[i][0] + v[i][1] + v[i][2] + v[i][3];
#pragma unroll
            for (int o = 32; o >= 1; o >>= 1) s += __shfl_xor(s, o);
            const float mean = s * (1.0f / DM);
            float q = 0.f;
#pragma unroll
            for (int i = 0; i < 4; ++i) { v[i] -= mean; q += v[i][0] * v[i][0] + v[i][1] * v[i][1] + v[i][2] * v[i][2] + v[i][3] * v[i][3]; }
#pragma unroll
            for (int o = 32; o >= 1; o >>= 1) q += __shfl_xor(q, o);
            const float rstd = rsqrtf(q * (1.0f / DM) + LN_EPS);
#pragma unroll
            for (int i = 0; i < 4; ++i) v[i] = v[i] * rstd * w4[i] + b4[i];
        }
        if (final_) {
            if (row < NLAT) {
#pragma unroll
                for (int i = 0; i < 4; ++i) ((f32x4*)(p.out + (size_t)row * DM))[lane + 64 * i] = v[i];
            }
        } else {
            const float* shp = ada_l + cond * 6144 + sh_idx * 1024;
#pragma unroll
            for (int i = 0; i < 4; ++i) {
                ((f32x4*)(X + (size_t)row * DM))[lane + 64 * i] = v[i];
                const f32x4 sh = ((const f32x4*)shp)[lane + 64 * i], scl = ((const f32x4*)(shp + 1024))[lane + 64 * i];
                const f32x4 h = v[i] * (scl + 1.0f) + sh;
                u32x2 w; w.x = cvt_pk_bf16(h[0], h[1]); w.y = cvt_pk_bf16(h[2], h[3]);
                ((u32x2*)(H + (size_t)row * DM))[lane + 64 * i] = w;
            }
        }
    }
}

__device__ __forceinline__ void phase_localkv(const Params& p, int l, unsigned char* lds_g) {
    const int bid_ = launder_s(blockIdx.x);
    bf16_t* Kf = (bf16_t*)lds_g; bf16_t* Kb = Kf + 64 * 136; bf16_t* Vt = Kb + 64 * 136;
    const int tid = launder_tid(), wave = tid >> 6, lane = tid & 63, fr = lane & 15, fq = lane >> 4;
    const bf16_t* QKVG = (const bf16_t*)(p.ws + OFF_R + R_QKVG);
    float* KV = (float*)(p.ws + OFF_R + R_KV);
    for (int item = bid_; item < NRC * 8; item += gridDim.x) {
        const int rc = item >> 3, h = item & 7;
        const float lf2 = -__expf(p.rate_f[l * 8 + h]) * LOG2E, lb2 = -__expf(p.rate_b[l * 8 + h]) * LOG2E;
        { const int j = tid >> 2, part = tid & 3;
          const bf16_t* kp = QKVG + (size_t)(rc * 128 + j) * 2048 + 512 + h * 64 + part * 16;
          const u32x4 k0 = *(const u32x4*)kp, k1 = *(const u32x4*)(kp + 8), v0 = *(const u32x4*)(kp + 512), v1 = *(const u32x4*)(kp + 520);
          const float wf = exp2f(lf2 * (float)(127 - j)), wb = exp2f(lb2 * (float)j);
          const unsigned kk[8] = {k0.x, k0.y, k0.z, k0.w, k1.x, k1.y, k1.z, k1.w};
          const unsigned vv[8] = {v0.x, v0.y, v0.z, v0.w, v1.x, v1.y, v1.z, v1.w};
#pragma unroll
          for (int e = 0; e < 8; ++e) {
              const float klo = bflo(kk[e]), khi = bfhi(kk[e]);
              const int d0 = part * 16 + 2 * e;
              Kf[d0 * 136 + j] = (bf16_t)f2bf(klo * wf); Kf[(d0 + 1) * 136 + j] = (bf16_t)f2bf(khi * wf);
              Kb[d0 * 136 + j] = (bf16_t)f2bf(klo * wb); Kb[(d0 + 1) * 136 + j] = (bf16_t)f2bf(khi * wb);
              Vt[d0 * 136 + j] = (bf16_t)(vv[e] & 0xffffu); Vt[(d0 + 1) * 136 + j] = (bf16_t)(vv[e] >> 16);
          } }
        __syncthreads();
        { const int dir = wave >> 2, vt = wave & 3;
          const bf16_t* Kd = dir ? Kb : Kf;
          bf16x8 a[4];
#pragma unroll
          for (int ks = 0; ks < 4; ++ks) a[ks] = *(const bf16x8*)(Vt + (vt * 16 + fr) * 136 + ks * 32 + fq * 8);
          float* KVp = KV + ((size_t)(dir * NRC + rc) * 8 + h) * 4096;
#pragma unroll
          for (int dt = 0; dt < 4; ++dt) {
              f32x4 acc = {0.f, 0.f, 0.f, 0.f};
#pragma unroll
              for (int ks = 0; ks < 4; ++ks) { const bf16x8 b = *(const bf16x8*)(Kd + (dt * 16 + fr) * 136 + ks * 32 + fq * 8); acc = __builtin_amdgcn_mfma_f32_16x16x32_bf16(a[ks], b, acc, 0, 0, 0); }
#pragma unroll
              for (int r = 0; r < 4; ++r) KVp[(vt * 16 + fq * 4 + r) * 64 + dt * 16 + fr] = acc[r];
          } }
        __syncthreads();
    }
}

__device__ __forceinline__ void phase_scan(const Params& p, int l) {
    const float* __restrict__ KV = (const float*)(p.ws + OFF_R + R_KV);
    bf16_t* __restrict__ ST = (bf16_t*)(p.ws + OFF_R + R_ST);
    for (int g = launder_s(blockIdx.x) * 512 + launder_tid(); g < 131072; g += gridDim.x * 512) {
        const int e = g & 4095, h = (g >> 12) & 7, b = (g >> 15) & 1, dir = g >> 16;
        const float lg = -__expf(dir ? p.rate_b[l * 8 + h] : p.rate_f[l * 8 + h]);
        const float decay = __expf(lg * 128.0f);
        float s = 0.f;
        float cur[13], nxt[13];
#define SCAN_IDX(step) ((((size_t)(dir * NRC + ((step) < 2 ? (256 + 2 * b + (dir ? 1 - (step) : (step))) : (128 * b + (dir ? 127 - ((step) - 2) : ((step) - 2))))) * 8 + h) << 12) + e)
#pragma unroll
        for (int i = 0; i < 13; ++i) cur[i] = KV[SCAN_IDX(i)];
        for (int bt = 0; bt < 10; ++bt) {
            if (bt < 9) {
#pragma unroll
                for (int i = 0; i < 13; ++i) nxt[i] = KV[SCAN_IDX((bt + 1) * 13 + i)];
            }
#pragma unroll
            for (int i = 0; i < 13; ++i) { ST[SCAN_IDX(bt * 13 + i)] = (bf16_t)f2bf(s); s = decay * s + cur[i]; }
#pragma unroll
            for (int i = 0; i < 13; ++i) cur[i] = nxt[i];
        }
#undef SCAN_IDX
    }
}

__device__ __forceinline__ void phase_retout(const Params& p, int l, int nitems, unsigned char* lds_g) {
    const int bid_ = launder_s(blockIdx.x);
    bf16_t* Qs = (bf16_t*)lds_g;
    bf16_t* Ks = Qs + 128 * 72;
    bf16_t* Vt = Ks + 128 * 72;
    bf16_t* Ps = Vt + 64 * 136;
    bf16_t* Sf = Ps + 128 * 136;
    bf16_t* Sb = Sf + 64 * 72;
    const int tid = launder_tid(), wave = tid >> 6, lane = tid & 63, fr = lane & 15, fq = lane >> 4;
    const bf16_t* QKVG = (const bf16_t*)(p.ws + OFF_R + R_QKVG);
    const bf16_t* ST = (const bf16_t*)(p.ws + OFF_R + R_ST);
    bf16_t* MIX = (bf16_t*)(p.ws + OFF_H);
    for (int item = bid_; item < nitems; item += gridDim.x) {
        const int rc = item >> 3, h = item & 7;
        const float lf2 = -__expf(p.rate_f[l * 8 + h]) * LOG2E, lb2 = -__expf(p.rate_b[l * 8 + h]) * LOG2E;
        { const int j = tid >> 2, part = tid & 3;
          const bf16_t* qp = QKVG + (size_t)(rc * 128 + j) * 2048 + h * 64 + part * 16;
          const u32x4 q0 = *(const u32x4*)qp, q1 = *(const u32x4*)(qp + 8), k0 = *(const u32x4*)(qp + 512), k1 = *(const u32x4*)(qp + 520);
          const u32x4 v0 = *(const u32x4*)(qp + 1024), v1 = *(const u32x4*)(qp + 1032);
          *(u32x4*)(Qs + j * 72 + part * 16) = q0; *(u32x4*)(Qs + j * 72 + part * 16 + 8) = q1;
          *(u32x4*)(Ks + j * 72 + part * 16) = k0; *(u32x4*)(Ks + j * 72 + part * 16 + 8) = k1;
          const unsigned vv[8] = {v0.x, v0.y, v0.z, v0.w, v1.x, v1.y, v1.z, v1.w};
#pragma unroll
          for (int e = 0; e < 8; ++e) { const int d0 = part * 16 + 2 * e; Vt[d0 * 136 + j] = (bf16_t)(vv[e] & 0xffffu); Vt[(d0 + 1) * 136 + j] = (bf16_t)(vv[e] >> 16); }
          const size_t so = ((size_t)rc * 8 + h) * 4096 + (size_t)tid * 8;
          const u32x4 sf = *(const u32x4*)(ST + so), sb = *(const u32x4*)(ST + (size_t)NRC * 8 * 4096 + so);
          *(u32x4*)(Sf + (tid >> 3) * 72 + (tid & 7) * 8) = sf; *(u32x4*)(Sb + (tid >> 3) * 72 + (tid & 7) * 8) = sb; }
        __syncthreads();
        const int i0 = wave * 16;
        bf16x8 qa[2];
#pragma unroll
        for (int ks = 0; ks < 2; ++ks) qa[ks] = *(const bf16x8*)(Qs + (i0 + fr) * 72 + ks * 32 + fq * 8);
#pragma unroll
        for (int jt = 0; jt < 8; ++jt) {
            f32x4 acc = {0.f, 0.f, 0.f, 0.f};
#pragma unroll
            for (int ks = 0; ks < 2; ++ks) { const bf16x8 kb = *(const bf16x8*)(Ks + (jt * 16 + fr) * 72 + ks * 32 + fq * 8); acc = __builtin_amdgcn_mfma_f32_16x16x32_bf16(qa[ks], kb, acc, 0, 0, 0); }
            const int j = jt * 16 + fr;
#pragma unroll
            for (int r = 0; r < 4; ++r) { const int i = i0 + fq * 4 + r; const int diff = i - j;
                const float mk = diff > 0 ? exp2f(lf2 * (float)diff) : (diff < 0 ? exp2f(lb2 * (float)(-diff)) : 2.0f);
                Ps[i * 136 + j] = (bf16_t)f2bf(acc[r] * mk); }
        }
        __syncthreads();
        bf16x8 pa[4];
#pragma unroll
        for (int ks = 0; ks < 4; ++ks) pa[ks] = *(const bf16x8*)(Ps + (i0 + fr) * 136 + ks * 32 + fq * 8);
        float o[4][4];
        float qdf[4], qdb[4];
#pragma unroll
        for (int r = 0; r < 4; ++r) { const int i = i0 + fq * 4 + r; qdf[r] = exp2f(lf2 * (float)(i + 1)); qdb[r] = exp2f(lb2 * (float)(128 - i)); }
#pragma unroll
        for (int vt = 0; vt < 4; ++vt) {
            f32x4 ao = {0.f, 0.f, 0.f, 0.f}, af = {0.f, 0.f, 0.f, 0.f}, ab = {0.f, 0.f, 0.f, 0.f};
#pragma unroll
            for (int ks = 0; ks < 4; ++ks) { const bf16x8 vb = *(const bf16x8*)(Vt + (vt * 16 + fr) * 136 + ks * 32 + fq * 8); ao = __builtin_amdgcn_mfma_f32_16x16x32_bf16(pa[ks], vb, ao, 0, 0, 0); }
#pragma unroll
            for (int ks = 0; ks < 2; ++ks) { const bf16x8 s1 = *(const bf16x8*)(Sf + (vt * 16 + fr) * 72 + ks * 32 + fq * 8); af = __builtin_amdgcn_mfma_f32_16x16x32_bf16(qa[ks], s1, af, 0, 0, 0);
                                             const bf16x8 s2 = *(const bf16x8*)(Sb + (vt * 16 + fr) * 72 + ks * 32 + fq * 8); ab = __builtin_amdgcn_mfma_f32_16x16x32_bf16(qa[ks], s2, ab, 0, 0, 0); }
#pragma unroll
            for (int r = 0; r < 4; ++r) o[vt][r] = ao[r] + qdf[r] * af[r] + qdb[r] * ab[r];
        }
#pragma unroll
        for (int r = 0; r < 4; ++r) {
            float s = o[0][r] + o[1][r] + o[2][r] + o[3][r];
            s += __shfl_xor(s, 1); s += __shfl_xor(s, 2); s += __shfl_xor(s, 4); s += __shfl_xor(s, 8);
            const float mean = s * (1.0f / 64.0f);
            float q = 0.f;
#pragma unroll
            for (int vt = 0; vt < 4; ++vt) { o[vt][r] -= mean; q += o[vt][r] * o[vt][r]; }
            q += __shfl_xor(q, 1); q += __shfl_xor(q, 2); q += __shfl_xor(q, 4); q += __shfl_xor(q, 8);
            const float rstd = rsqrtf(q * (1.0f / 64.0f) + LN_EPS);
            const int row = rc * 128 + i0 + fq * 4 + r;
#pragma unroll
            for (int vt = 0; vt < 4; ++vt) {
                const int col = h * 64 + vt * 16 + fr;
                float y = o[vt][r] * rstd * p.gn_w[l * 512 + col] + p.gn_b[l * 512 + col];
                y = bf2f(f2bf(y));
                const float g = bf2f((unsigned)QKVG[(size_t)row * 2048 + 1536 + col]);
                MIX[(size_t)row * DM + col] = (bf16_t)f2bf(g * sigmoidf_(g) * y);
            }
        }
        __syncthreads();
    }
}

__device__ __forceinline__ void phase_conv(const Params& p, int l, int nitems, unsigned char* lds_g) {
    const int bid_ = launder_s(blockIdx.x);
    float* tile = (float*)lds_g;
    float* stat = tile + 32 * 512;
    const int tid = launder_tid(), wave = tid >> 6, lane = tid & 63;
    const bf16_t* U = (const bf16_t*)(p.ws + OFF_R + R_U);
    bf16_t* MIX = (bf16_t*)(p.ws + OFF_H);
    float w[31];
#pragma unroll
    for (int k = 0; k < 31; ++k) w[k] = p.conv_w[((size_t)l * 31 + k) * 512 + tid];
    const float cb = p.conv_b[l * 512 + tid], lw = p.cln_w[l * 512 + tid], lb = p.cln_b[l * 512 + tid];
    for (int item = bid_; item < nitems; item += gridDim.x) {
        const int t0 = item * 32;
        int lo, hi;
        if (t0 < NLAT) { lo = t0 & ~(SEQL - 1); hi = lo + SEQL; } else { lo = NLAT + ((t0 - NLAT) & ~255); hi = lo + 256; }
        float acc[32];
#pragma unroll
        for (int t = 0; t < 32; ++t) acc[t] = cb;
#pragma unroll
        for (int r = 0; r < 62; ++r) {
            const int row = t0 - 15 + r;
            float val = 0.f;
            if (row >= lo && row < hi) val = bf2f((unsigned)U[(size_t)row * 512 + tid]);
#pragma unroll
            for (int t = 0; t < 32; ++t) { const int k = r - t; if (k >= 0 && k <= 30) acc[t] += val * w[k]; }
        }
#pragma unroll
        for (int t = 0; t < 32; ++t) tile[t * 512 + tid] = acc[t];
        __syncthreads();
#pragma unroll
        for (int tt = 0; tt < 4; ++tt) {
            const int t = wave * 4 + tt;
            float v[8]; float s = 0.f;
#pragma unroll
            for (int i = 0; i < 8; ++i) { v[i] = tile[t * 512 + lane + 64 * i]; s += v[i]; }
#pragma unroll
            for (int o = 32; o >= 1; o >>= 1) s += __shfl_xor(s, o);
            const float mean = s * (1.0f / 512.0f);
            float q = 0.f;
#pragma unroll
            for (int i = 0; i < 8; ++i) { const float d = v[i] - mean; q += d * d; }
#pragma unroll
            for (int o = 32; o >= 1; o >>= 1) q += __shfl_xor(q, o);
            if (lane == 0) { stat[2 * t] = mean; stat[2 * t + 1] = rsqrtf(q * (1.0f / 512.0f) + LN_EPS); }
        }
        __syncthreads();
#pragma unroll
        for (int t = 0; t < 32; ++t) {
            const float y = (acc[t] - stat[2 * t]) * stat[2 * t + 1] * lw + lb;
            MIX[(size_t)(t0 + t) * DM + 512 + tid] = (bf16_t)f2bf(y * sigmoidf_(y));
        }
        __syncthreads();
    }
}

__global__ void __launch_bounds__(512, 2) fwd_megakernel(Params p) {
    extern __shared__ __attribute__((aligned(16))) unsigned char lds[];
    cg::grid_group grid = cg::this_grid();
    LAS unsigned char* ldsl = (LAS unsigned char*)lds;
    const int G = gridDim.x, bid = blockIdx.x;
    float* X = (float*)(p.ws + OFF_X);
    bf16_t* H = (bf16_t*)(p.ws + OFF_H);
    const float* ADA = (const float*)(p.ws + OFF_ADA);
    bf16_t* WIN = (bf16_t*)(p.ws + OFF_WIN); bf16_t* WOUT = (bf16_t*)(p.ws + OFF_WOUT); bf16_t* WFF1 = (bf16_t*)(p.ws + OFF_WFF1); bf16_t* WFF2 = (bf16_t*)(p.ws + OFF_WFF2);
    bf16_t* QKVG = (bf16_t*)(p.ws + OFF_R + R_QKVG); bf16_t* U = (bf16_t*)(p.ws + OFF_R + R_U); bf16_t* HM = (bf16_t*)(p.ws + OFF_R);

    phase_adaln_rope(p, lds);
    convert_weights(p, 0, lds);
    grid.sync();
    row_pass(p, MTOT, nullptr, nullptr, ADA, 0, true, false);
    grid.sync();

    for (int l = 0; l < DEPTH; ++l) {
        const bool last = (l == DEPTH - 1);
        const int Ml = last ? NLAT : MTOT;
        const float* ada_l = ADA + (size_t)l * 3 * 6144;
        {
            pg8::Gemm g{H, WIN, MTOT, INW, DM}; pg8::StaticOrder S; S.init(MTOT, INW, G, launder_s(blockIdx.x));
            EpiInProj E{QKVG, U, (const float*)(p.ws + OFF_ROPE), last ? 1 : 0};
            pg8::gemm_phase<EpiInProj>(ldsl, g, S, E);
        }
        grid.sync();
        phase_localkv(p, l, lds);
        phase_conv(p, l, Ml / 32, lds);
        grid.sync();
        phase_scan(p, l);
        grid.sync();
        phase_retout(p, l, (Ml / 128) * 8, lds);
        grid.sync();
        {
            pg8::Gemm g{H, WOUT, Ml, DM, DM}; pg8::StaticOrder S; S.init(Ml, DM, G, launder_s(blockIdx.x));
            EpiRes E{X, ada_l + 2 * 1024};
            pg8::gemm_phase<EpiRes>(ldsl, g, S, E);
        }
        grid.sync();
        row_pass(p, Ml, p.ln1_w + l * DM, p.ln1_b + l * DM, ada_l, 3, false, false);
        grid.sync();
        {
            pg8::Gemm g{H, WFF1, Ml, DFF, DM}; pg8::StaticOrder S; S.init(Ml, DFF, G, launder_s(blockIdx.x));
            EpiFF1 E{HM};
            pg8::gemm_phase<EpiFF1>(ldsl, g, S, E);
        }
        grid.sync();
        {
            pg8::Gemm g{HM, WFF2, Ml, DM, DFF}; pg8::StaticOrder S; S.init(Ml, DM, G, launder_s(blockIdx.x));
            EpiRes E{X, ada_l + 5 * 1024};
            pg8::gemm_phase<EpiRes>(ldsl, g, S, E);
        }
        grid.sync();
        if (!last) {
            row_pass(p, MTOT, p.ln2_w + l * DM, p.ln2_b + l * DM, ada_l + 3 * 6144, 0, false, false);
            convert_weights(p, l + 1, lds);
            grid.sync();
        } else {
            row_pass(p, NLAT, p.ln2_w + l * DM, p.ln2_b + l * DM, ada_l, 0, false, true);
        }
    }
}

extern "C" void kernel_launch(void* const* d_in, const int* in_sizes, int n_in, void* d_out, int out_size, void* d_ws, size_t ws_size, hipStream_t stream) {
    static int grid_blocks = 0;
    if (grid_blocks == 0) {
        if (n_in != 22 || ws_size < WS_END) { fprintf(stderr, "kernel_launch: need 22 inputs and %zu bytes of workspace (got %d, %zu)\n", (size_t)WS_END, n_in, ws_size); grid_blocks = -1; return; }
        int dev = 0, cus = 0, per_cu = 0;
        hipGetDevice(&dev);
        hipDeviceGetAttribute(&cus, hipDeviceAttributeMultiprocessorCount, dev);
        hipFuncSetAttribute((const void*)fwd_megakernel, hipFuncAttributeMaxDynamicSharedMemorySize, LDS_BYTES);
        hipOccupancyMaxActiveBlocksPerMultiprocessor(&per_cu, (const void*)fwd_megakernel, 512, LDS_BYTES);
        if (per_cu < 1) { fprintf(stderr, "kernel_launch: occupancy query says %d blocks per CU\n", per_cu); per_cu = 1; }
        (void)hipGetLastError();
        grid_blocks = cus * 1;
    }
    if (grid_blocks < 0) return;
    Params p{};
    const float** pp = (const float**)&p;
    for (int i = 0; i < 22; ++i) pp[i] = (const float*)d_in[i];
    p.out = (float*)d_out; p.ws = (unsigned char*)d_ws;
    void* args[] = {&p};
    hipError_t e = hipLaunchCooperativeKernel((const void*)fwd_megakernel, dim3(grid_blocks), dim3(512), args, LDS_BYTES, stream);
    if (e != hipSuccess) fprintf(stderr, "cooperative launch failed: %s (grid %d)\n", hipGetErrorString(e), grid_blocks);
}
```

```cpp
#include <hip/hip_runtime.h>
#include <hip/hip_cooperative_groups.h>
#include <cstdio>
namespace cg = cooperative_groups;

#define LAS __attribute__((address_space(3)))
typedef unsigned short bf16_t;
typedef short bf16x8 __attribute__((ext_vector_type(8)));
typedef float f32x4 __attribute__((ext_vector_type(4)));
typedef unsigned u32x4 __attribute__((ext_vector_type(4)));
typedef unsigned u32x2 __attribute__((ext_vector_type(2)));

constexpr int DM = 1024, NLAT = 32768, MTOT = 33280, SEQL = 16384, DEPTH = 4;
constexpr int INW = 3072, DFF = 4096, NRC = 260  ;
constexpr float LN_EPS = 1e-5f;
constexpr float ALPHA = 1.681792830507429f;
constexpr float LOG2E = 1.4426950408889634f;

constexpr size_t OFF_WIN = 0;
constexpr size_t OFF_WOUT = OFF_WIN + (size_t)INW * DM * 2;
constexpr size_t OFF_WFF1 = OFF_WOUT + (size_t)DM * DM * 2;
constexpr size_t OFF_WFF2 = OFF_WFF1 + (size_t)DFF * DM * 2;
constexpr size_t OFF_ADA = OFF_WFF2 + (size_t)DFF * DM * 2;
constexpr size_t OFF_ROPE = OFF_ADA + (size_t)DEPTH * 3 * 6144 * 4;
constexpr size_t OFF_X = OFF_ROPE + 256 * 16 * 8;
constexpr size_t OFF_H = OFF_X + (size_t)MTOT * DM * 4;
constexpr size_t OFF_R = OFF_H + (size_t)MTOT * DM * 2;
constexpr size_t R_QKVG = 0;
constexpr size_t R_U = R_QKVG + (size_t)MTOT * 2048 * 2;
constexpr size_t R_KV = R_U + (size_t)MTOT * 512 * 2;
constexpr size_t R_ST = R_KV + (size_t)2 * NRC * 8 * 4096 * 4;
constexpr size_t R_END = R_ST + (size_t)2 * NRC * 8 * 4096 * 2;
constexpr size_t HM_BYTES = (size_t)MTOT * DFF * 2;
constexpr size_t WS_END = OFF_R + (R_END > HM_BYTES ? R_END : HM_BYTES);
constexpr size_t OFF_CTL = (WS_END + 255) / 256 * 256;
constexpr int XCD_BAR_WORDS_C = 3456;
constexpr size_t CTL_BYTES = (size_t)XCD_BAR_WORDS_C * 4;
constexpr size_t WS_NEED = OFF_CTL + CTL_BYTES;
constexpr int LDS_BYTES = 131072 + 64;

struct Params {
    const float *x, *c, *ctx, *c_ctx, *w_ada, *b_ada, *w_in, *rate_f, *rate_b, *gn_w, *gn_b, *conv_w, *conv_b, *cln_w, *cln_b, *w_out,
        *ln1_w, *ln1_b, *w_ff1, *w_ff2, *ln2_w, *ln2_b;
    float* out;
    unsigned char* ws;
};

__device__ __forceinline__ unsigned f2bf(float f) { unsigned u = __builtin_bit_cast(unsigned, f); return (u + 0x7fffu + ((u >> 16) & 1u)) >> 16; }
__device__ __forceinline__ float bf2f(unsigned b) { return __builtin_bit_cast(float, b << 16); }
__device__ __forceinline__ float bflo(unsigned u) { return __builtin_bit_cast(float, u << 16); }
__device__ __forceinline__ float bfhi(unsigned u) { return __builtin_bit_cast(float, u & 0xffff0000u); }
__device__ __forceinline__ unsigned cvt_pk_bf16(float lo, float hi) { unsigned r; asm volatile("v_cvt_pk_bf16_f32 %0, %1, %2" : "=v"(r) : "v"(lo), "v"(hi)); return r; }
__device__ __forceinline__ int launder_tid() { int t = threadIdx.x; asm volatile("" : "+v"(t)); return t; }
__device__ __forceinline__ int launder_s(int v) { asm volatile("" : "+s"(v)); return v; }
template <class T> __device__ __forceinline__ T* launder_p(T* q) { asm volatile("" : "+s"(q)); return q; }
__device__ __forceinline__ float sigmoidf_(float v) { return 1.0f / (1.0f + __expf(-v)); }

namespace pg8 {
constexpr int BM = 256, BK = 64, HALF = 128, HTB = HALF * BK * 2, STAGE_BYTES = 8 * HTB, NXCD = 8, WGM = 8;
__host__ __device__ __forceinline__ int lds_byte(int r, int c) { const int st = (r >> 4) * 2 + (c >> 5), rr = r & 15, cc = c & 31, ob = rr * 64 + cc * 2; return st * 1024 + (ob ^ (((ob >> 9) & 1) << 5)); }
__host__ __device__ __forceinline__ void stage_rc(int b, int& R, int& C) { const int st = b / 1024, sb = b % 1024, swz = sb ^ (((sb >> 9) & 1) << 5); R = (st >> 1) * 16 + swz / 64; C = (st & 1) * 32 + (swz % 64) / 2; }
__host__ __device__ __forceinline__ int perm32(int rho) { const int n = rho >> 4, i = rho & 15; return 8 * (i >> 2) + 4 * n + (i & 3); }

struct Unit { int pm, pn; };
struct Gemm { const bf16_t* A; const bf16_t* Bt; int M, N, K; };

struct StaticOrder {
    int nM, nN, nwg, G, c;
    __device__ void init(int M, int N, int G_, int c_) { nM = M / BM; nN = N / BM; nwg = nM * nN; G = G_; c = c_; }
    __device__ bool next(int i, Unit& u) const {
        const long L = (long)i * G + c; if (L >= nwg) return false;
        int wgid = (int)L; { const int q = nwg / NXCD, r = nwg % NXCD, xcd = wgid % NXCD, off = wgid / NXCD; wgid = (xcd < r ? xcd * (q + 1) : r * (q + 1) + (xcd - r) * q) + off; }
        const int nig = WGM * nN, gid = wgid / nig, fm = gid * WGM, gsz = (nM - fm) < WGM ? (nM - fm) : WGM;
        u.pm = fm + ((wgid % nig) % gsz); u.pn = (wgid % nig) / gsz; return true;
    }
};

template <class Epi>
__device__ __forceinline__ void gemm_phase(LAS unsigned char* lds, const Gemm g, const StaticOrder& S, const Epi& E) {
    const int tid = launder_tid(), wid = __builtin_amdgcn_readfirstlane(tid >> 6), lane = tid & 63, wr = wid >> 2, wc = wid & 3, fr = lane & 15, fq = lane >> 4;
    const int K = g.K, nt = K / BK;
    unsigned voffA[2], voffB[2];
#pragma unroll
    for (int i = 0; i < 2; ++i) { int R, C; stage_rc(tid * 16 + i * 8192, R, C); const int Rb = Epi::PERM ? ((R & ~31) + perm32(R & 31)) : R;
        voffA[i] = (unsigned)(R * K + C) * 2u; voffB[i] = (unsigned)(Rb * K + C) * 2u; }
    const size_t kstep = (size_t)(BK * 2);
    const size_t hstep = (size_t)HALF * K * 2;
    const size_t tstep = 2 * hstep;
    const unsigned ldsw = (unsigned)wid * 1024u;
    const int aoff = lds_byte(wr * 64 + fr, fq * 8), boff = lds_byte(wc * 32 + fr, fq * 8);
#define PG8_SA(b, h) (((b) * 2 + (h)) * HTB)
#define PG8_SB(b, h) ((4 + (b) * 2 + (h)) * HTB)
#define PG8_STAGE(bufoff, gbase, voff) do { _Pragma("unroll") for (int _i = 0; _i < 2; ++_i) \
        __builtin_amdgcn_global_load_lds((const unsigned*)((const char*)(gbase) + (voff)[_i]), (LAS unsigned*)(lds + (bufoff) + ldsw + _i * 8192), 16, 0, 0); } while (0)
#define PG8_LDA(dst, b, h) do { _Pragma("unroll") for (int m = 0; m < 4; ++m) _Pragma("unroll") for (int k = 0; k < 2; ++k) dst[m][k] = *(const LAS bf16x8*)(lds + PG8_SA(b, h) + aoff + m * 2048 + k * 1024); } while (0)
#define PG8_LDB(dst, b, h) do { _Pragma("unroll") for (int n = 0; n < 2; ++n) _Pragma("unroll") for (int k = 0; k < 2; ++k) dst[n][k] = *(const LAS bf16x8*)(lds + PG8_SB(b, h) + boff + n * 2048 + k * 1024); } while (0)
#define PG8_MMA(ai, bj, At, Bt) do { __builtin_amdgcn_s_setprio(1); _Pragma("unroll") for (int m = 0; m < 4; ++m) _Pragma("unroll") for (int n = 0; n < 2; ++n) _Pragma("unroll") for (int k = 0; k < 2; ++k) \
        acc[ai][bj][m][n] = __builtin_amdgcn_mfma_f32_16x16x32_bf16(Bt[n][k], At[m][k], acc[ai][bj][m][n], 0, 0, 0); __builtin_amdgcn_s_setprio(0); } while (0)
#define PG8_WAIT_V(n) asm volatile("s_waitcnt vmcnt(" #n ")" ::: "memory")
#define PG8_WAIT_L(n) asm volatile("s_waitcnt lgkmcnt(" #n ")" ::: "memory")
#define PG8_BAR __builtin_amdgcn_s_barrier()
#define PG8_SCHED __builtin_amdgcn_sched_barrier(0)
    Unit cur, nxt; int ui = 0;
    if (!S.next(0, cur)) return;
    f32x4 acc[2][2][4][2];
#pragma unroll
    for (int a = 0; a < 2; ++a)
#pragma unroll
        for (int b = 0; b < 2; ++b)
#pragma unroll
            for (int m = 0; m < 4; ++m)
#pragma unroll
                for (int n = 0; n < 2; ++n) acc[a][b][m][n] = (f32x4){0.f, 0.f, 0.f, 0.f};
    bf16x8 At[4][2], B0[2][2], B1[2][2];
    const char* cA = (const char*)g.A + (size_t)cur.pm * tstep; const char* cB = (const char*)g.Bt + (size_t)cur.pn * tstep;
    PG8_STAGE(PG8_SB(0, 0), cB, voffB); PG8_STAGE(PG8_SB(0, 1), cB + hstep, voffB); PG8_STAGE(PG8_SA(0, 0), cA, voffA); PG8_STAGE(PG8_SA(0, 1), cA + hstep, voffA);
    if (wr == 1) PG8_BAR;
    PG8_WAIT_V(2); PG8_BAR;
    PG8_STAGE(PG8_SB(1, 0), cB + kstep, voffB); PG8_STAGE(PG8_SA(1, 0), cA + kstep, voffA); PG8_STAGE(PG8_SB(1, 1), cB + hstep + kstep, voffB);
    PG8_WAIT_V(6); PG8_BAR;
    for (;;) {
        const bool has_next = S.next(ui + 1, nxt);
        const char* nA = has_next ? (const char*)g.A + (size_t)nxt.pm * tstep : cA; const char* nB = has_next ? (const char*)g.Bt + (size_t)nxt.pn * tstep : cB;
        for (int t = 0; t < nt; t += 2) {
            const bool last = (t == nt - 2);
            const char* a1 = cA + (size_t)(t + 1) * kstep;
            const char* a2 = last ? nA : cA + (size_t)(t + 2) * kstep; const char* b2 = last ? nB : cB + (size_t)(t + 2) * kstep;
            const char* a3 = a2 + kstep; const char* b3 = b2 + kstep;
            PG8_LDB(B0, 0, 0); PG8_LDB(B1, 0, 1); PG8_SCHED; PG8_LDA(At, 0, 0); PG8_STAGE(PG8_SA(1, 1), a1 + hstep, voffA);
            PG8_WAIT_V(8); PG8_WAIT_L(0); PG8_BAR; PG8_MMA(0, 0, At, B0); PG8_MMA(0, 1, At, B1); PG8_BAR; PG8_SCHED;
            PG8_LDA(At, 0, 1); PG8_STAGE(PG8_SB(0, 0), b2, voffB); PG8_STAGE(PG8_SB(0, 1), b2 + hstep, voffB); PG8_STAGE(PG8_SA(0, 0), a2, voffA);
            PG8_WAIT_V(8); PG8_WAIT_L(0); PG8_BAR; PG8_MMA(1, 0, At, B0); PG8_MMA(1, 1, At, B1); PG8_BAR; PG8_SCHED;
            PG8_LDB(B0, 1, 0); PG8_LDB(B1, 1, 1); PG8_SCHED; PG8_LDA(At, 1, 0); PG8_STAGE(PG8_SA(0, 1), a2 + hstep, voffA);
            PG8_WAIT_V(8); PG8_WAIT_L(0); PG8_BAR; PG8_MMA(0, 0, At, B0); PG8_MMA(0, 1, At, B1); PG8_BAR; PG8_SCHED;
            PG8_LDA(At, 1, 1); PG8_STAGE(PG8_SB(1, 0), b3, voffB); PG8_STAGE(PG8_SB(1, 1), b3 + hstep, voffB); PG8_STAGE(PG8_SA(1, 0), a3, voffA);
            PG8_WAIT_V(8); PG8_WAIT_L(0); PG8_BAR; PG8_MMA(1, 0, At, B0); PG8_MMA(1, 1, At, B1); PG8_BAR; PG8_SCHED;
        }
        if (wr == 0) PG8_BAR;
        E(acc, cur, wr, wc, fr, fq);
        if (!has_next) break;
#pragma unroll
        for (int a = 0; a < 2; ++a)
#pragma unroll
            for (int b = 0; b < 2; ++b)
#pragma unroll
                for (int m = 0; m < 4; ++m)
#pragma unroll
                    for (int n = 0; n < 2; ++n) acc[a][b][m][n] = (f32x4){0.f, 0.f, 0.f, 0.f};
        cur = nxt; cA = nA; cB = nB; ++ui;
        if (wr == 1) PG8_BAR;
    }
    PG8_WAIT_V(0);
    PG8_BAR;
#undef PG8_SA
#undef PG8_SB
#undef PG8_STAGE
#undef PG8_LDA
#undef PG8_LDB
#undef PG8_MMA
#undef PG8_WAIT_V
#undef PG8_WAIT_L
#undef PG8_BAR
#undef PG8_SCHED
}
}

struct EpiInProj {
    static constexpr bool PERM = true;
    bf16_t* QKVG; bf16_t* U; const float* rope; int last;
    __device__ __forceinline__ void operator()(const f32x4 (&acc)[2][2][4][2], const pg8::Unit& u, int wr, int wc, int fr, int fq) const {
        const int row0 = u.pm * 256 + wr * 64 + fr;
        const bool is_ctx = u.pm >= 128;
        if (u.pn < 8) {
            const int colb = u.pn * 256 + wc * 32 + 8 * fq;
            const bool do_rope = (u.pn < 4) && !is_ctx;
            const float kscale = (u.pn >= 2 && u.pn < 4 && !(is_ctx && last)) ? 0.125f : 1.0f;
#pragma unroll
            for (int ai = 0; ai < 2; ++ai)
#pragma unroll
                for (int m = 0; m < 4; ++m) {
                    const int row = row0 + ai * 128 + m * 16;
                    f32x4 cs0 = {1.f, 0.f, 1.f, 0.f}, cs1 = {1.f, 0.f, 1.f, 0.f};
                    if (do_rope) { const int pos = (wc & 1) ? (row & 63) : ((row & (SEQL - 1)) >> 6);
                        const f32x4* rp = (const f32x4*)(rope + (size_t)(pos * 16 + 4 * fq) * 2); cs0 = rp[0]; cs1 = rp[1]; }
                    bf16_t* rowp = QKVG + (size_t)row * 2048 + colb;
#pragma unroll
                    for (int bj = 0; bj < 2; ++bj) {
                        f32x4 v0 = acc[ai][bj][m][0], v1 = acc[ai][bj][m][1];
                        if (do_rope) {
                            f32x4 w0, w1;
                            w0[0] = v0[0] * cs0[0] - v0[1] * cs0[1]; w0[1] = v0[0] * cs0[1] + v0[1] * cs0[0];
                            w0[2] = v0[2] * cs0[2] - v0[3] * cs0[3]; w0[3] = v0[2] * cs0[3] + v0[3] * cs0[2];
                            w1[0] = v1[0] * cs1[0] - v1[1] * cs1[1]; w1[1] = v1[0] * cs1[1] + v1[1] * cs1[0];
                            w1[2] = v1[2] * cs1[2] - v1[3] * cs1[3]; w1[3] = v1[2] * cs1[3] + v1[3] * cs1[2];
                            v0 = w0; v1 = w1;
                        }
                        v0 *= kscale; v1 *= kscale;
                        u32x4 w; w.x = cvt_pk_bf16(v0[0], v0[1]); w.y = cvt_pk_bf16(v0[2], v0[3]); w.z = cvt_pk_bf16(v1[0], v1[1]); w.w = cvt_pk_bf16(v1[2], v1[3]);
                        *(u32x4*)(rowp + bj * 128) = w;
                    }
                }
        } else {
            const int colb = (u.pn - 8) * 128 + wc * 32 + 8 * fq;
#pragma unroll
            for (int ai = 0; ai < 2; ++ai)
#pragma unroll
                for (int m = 0; m < 4; ++m) {
                    const int row = row0 + ai * 128 + m * 16;
                    f32x4 a0 = acc[ai][0][m][0], a1 = acc[ai][0][m][1], g0 = acc[ai][1][m][0], g1 = acc[ai][1][m][1];
#pragma unroll
                    for (int j = 0; j < 4; ++j) { a0[j] *= sigmoidf_(g0[j]); a1[j] *= sigmoidf_(g1[j]); }
                    u32x4 w; w.x = cvt_pk_bf16(a0[0], a0[1]); w.y = cvt_pk_bf16(a0[2], a0[3]); w.z = cvt_pk_bf16(a1[0], a1[1]); w.w = cvt_pk_bf16(a1[2], a1[3]);
                    *(u32x4*)(U + (size_t)row * 512 + colb) = w;
                }
        }
    }
};
struct EpiRes {
    static constexpr bool PERM = false;
    float* X; const float* gate;
    __device__ __forceinline__ void operator()(const f32x4 (&acc)[2][2][4][2], const pg8::Unit& u, int wr, int wc, int fr, int fq) const {
        const int row0 = u.pm * 256 + wr * 64 + fr, col0 = u.pn * 256 + wc * 32 + 4 * fq;
        const int cond = u.pm < 64 ? 0 : (u.pm < 128 ? 1 : 2);
        const float* gp = gate + cond * 6144 + col0;
        f32x4 gv[2][2];
#pragma unroll
        for (int bj = 0; bj < 2; ++bj)
#pragma unroll
            for (int n = 0; n < 2; ++n) gv[bj][n] = *(const f32x4*)(gp + bj * 128 + n * 16);
#pragma unroll
        for (int ai = 0; ai < 2; ++ai)
#pragma unroll
            for (int m = 0; m < 4; ++m) { float* rowp = X + (size_t)(row0 + ai * 128 + m * 16) * DM + col0;
#pragma unroll
                for (int bj = 0; bj < 2; ++bj)
#pragma unroll
                    for (int n = 0; n < 2; ++n) { f32x4 xv = *(const f32x4*)(rowp + bj * 128 + n * 16); xv = xv * ALPHA + gv[bj][n] * acc[ai][bj][m][n]; *(f32x4*)(rowp + bj * 128 + n * 16) = xv; } }
    }
};
struct EpiFF1 {
    static constexpr bool PERM = true;
    bf16_t* O;
    __device__ __forceinline__ void operator()(const f32x4 (&acc)[2][2][4][2], const pg8::Unit& u, int wr, int wc, int fr, int fq) const {
        const int row0 = u.pm * 256 + wr * 64 + fr, col0 = u.pn * 256 + wc * 32 + 8 * fq;
#pragma unroll
        for (int ai = 0; ai < 2; ++ai)
#pragma unroll
            for (int m = 0; m < 4; ++m) { bf16_t* rowp = O + (size_t)(row0 + ai * 128 + m * 16) * DFF + col0;
#pragma unroll
                for (int bj = 0; bj < 2; ++bj) { f32x4 v0 = acc[ai][bj][m][0], v1 = acc[ai][bj][m][1];
#pragma unroll
                    for (int j = 0; j < 4; ++j) { float a = fmaxf(v0[j], 0.f), b = fmaxf(v1[j], 0.f); v0[j] = a * a; v1[j] = b * b; }
                    u32x4 w; w.x = cvt_pk_bf16(v0[0], v0[1]); w.y = cvt_pk_bf16(v0[2], v0[3]); w.z = cvt_pk_bf16(v1[0], v1[1]); w.w = cvt_pk_bf16(v1[2], v1[3]);
                    *(u32x4*)(rowp + bj * 128) = w; } }
    }
};

__device__ __forceinline__ void convert_weights(const Params& p, int l, unsigned char* lds_g) {
    const int bid_ = launder_s(blockIdx.x);
    float* ls = (float*)lds_g;
    const int tid = launder_tid();
    for (int t = bid_; t < 3072; t += gridDim.x) {
        const float* W; bf16_t* Wt; int K, N, tt;
        if (t < 768) { W = p.w_in + (size_t)l * DM * INW; Wt = (bf16_t*)(p.ws + OFF_WIN); K = DM; N = INW; tt = t; }
        else if (t < 1024) { W = p.w_out + (size_t)l * DM * DM; Wt = (bf16_t*)(p.ws + OFF_WOUT); K = DM; N = DM; tt = t - 768; }
        else if (t < 2048) { W = p.w_ff1 + (size_t)l * DM * DFF; Wt = (bf16_t*)(p.ws + OFF_WFF1); K = DM; N = DFF; tt = t - 1024; }
        else { W = p.w_ff2 + (size_t)l * DFF * DM; Wt = (bf16_t*)(p.ws + OFF_WFF2); K = DFF; N = DM; tt = t - 2048; }
        const int ntn = N / 64, k0 = (tt / ntn) * 64, n0 = (tt % ntn) * 64;
#pragma unroll
        for (int i = 0; i < 8; ++i) { const int k = (tid >> 6) + 8 * i, n = tid & 63; ls[k * 65 + n] = W[(size_t)(k0 + k) * N + n0 + n]; }
        __syncthreads();
        { const int n = tid >> 3, kk = (tid & 7) * 8;
          float v[8];
#pragma unroll
          for (int j = 0; j < 8; ++j) v[j] = ls[(kk + j) * 65 + n];
          int nn = n0 + n;
          if (t < 768 && nn >= 2048) { const int isb = nn >= 2560; const int cc = nn - (isb ? 2560 : 2048); nn = 2048 + 256 * (cc >> 7) + 128 * isb + (cc & 127); }
          u32x4 w; w.x = cvt_pk_bf16(v[0], v[1]); w.y = cvt_pk_bf16(v[2], v[3]); w.z = cvt_pk_bf16(v[4], v[5]); w.w = cvt_pk_bf16(v[6], v[7]);
          *(u32x4*)(Wt + (size_t)nn * K + k0 + kk) = w; }
        __syncthreads();
    }
}

__device__ __forceinline__ void phase_adaln_rope(const Params& p, unsigned char* lds_g) {
    const int bid_ = launder_s(blockIdx.x);
    float* sc = (float*)lds_g;
    float* red = sc + 3 * 1024;
    const int tid = launder_tid(), wave = tid >> 6, lane = tid & 63;
    for (int e = bid_ * 512 + tid; e < 256 * 16; e += gridDim.x * 512) {
        const int pos = e >> 4, f = e & 15;
        const float inv = powf(10000.0f, -(float)f / 16.0f);
        const float angf = (float)pos * inv;
        double a = (double)angf;
        const double twopi = 6.283185307179586476925;
        a -= twopi * rint(a / twopi);
        const double a2 = a * a;
        double sn = 0.0, cn = 0.0, ts = a, tc = 1.0;
        for (int i = 0; i < 16; ++i) { cn += tc; sn += ts; tc = -tc * a2 / (double)((2 * i + 1) * (2 * i + 2)); ts = -ts * a2 / (double)((2 * i + 2) * (2 * i + 3)); }
        float* rp = (float*)(p.ws + OFF_ROPE);
        rp[2 * e] = (float)cn; rp[2 * e + 1] = (float)sn;
    }
    for (int i = tid; i < 3072; i += 512) { const float v = i < 2048 ? p.c[i] : p.c_ctx[i - 2048]; sc[i] = v * sigmoidf_(v); }
    __syncthreads();
    float* ADA = (float*)(p.ws + OFF_ADA);
    for (int item = bid_; item < DEPTH * 96; item += gridDim.x) {
        const int l = item / 96, n0 = (item % 96) * 64;
        const float* W = p.w_ada + (size_t)l * DM * 6144 + n0 + lane;
        float a0 = 0.f, a1 = 0.f, a2 = 0.f;
        const int kb = wave * 128;
#pragma unroll 8
        for (int k = 0; k < 128; ++k) { const float w = W[(size_t)(kb + k) * 6144]; a0 += sc[kb + k] * w; a1 += sc[1024 + kb + k] * w; a2 += sc[2048 + kb + k] * w; }
        red[(wave * 3 + 0) * 64 + lane] = a0; red[(wave * 3 + 1) * 64 + lane] = a1; red[(wave * 3 + 2) * 64 + lane] = a2;
        __syncthreads();
        if (tid < 192) { const int j = tid >> 6; float s = 0.f;
#pragma unroll
            for (int w = 0; w < 8; ++w) s += red[(w * 3 + j) * 64 + lane];
            ADA[(size_t)(l * 3 + j) * 6144 + n0 + lane] = s + p.b_ada[l * 6144 + n0 + lane]; }
        __syncthreads();
    }
}

__device__ __forceinline__ void row_pass(const Params& p, int nrows, const float* lnw, const float* lnb, const float* ada_l, int sh_idx, bool init, bool final_) {
    const int tid = launder_tid(), wave = tid >> 6, lane = tid & 63;
    float* X = (float*)(p.ws + OFF_X); bf16_t* H = (bf16_t*)(p.ws + OFF_H);
    f32x4 w4[4], b4[4];
    if (!init) {
#pragma unroll
        for (int i = 0; i < 4; ++i) { w4[i] = ((const f32x4*)lnw)[lane + 64 * i]; b4[i] = ((const f32x4*)lnb)[lane + 64 * i]; }
    }
    for (int row = launder_s(blockIdx.x) * 8 + wave; row < nrows; row += gridDim.x * 8) {
        const int cond = row < SEQL ? 0 : (row < NLAT ? 1 : 2);
        const float* src = init ? (row < NLAT ? p.x + (size_t)row * DM : p.ctx + (size_t)(row - NLAT) * DM) : X + (size_t)row * DM;
        f32x4 v[4];
#pragma unroll
        for (int i = 0; i < 4; ++i) v[i] = ((const f32x4*)src)[lane + 64 * i];
        if (!init) {
            float s = 0.f;
#pragma unroll
            for (int i = 0; i < 4; ++i) s += v[i][0] + v[i][1] + v[i][2] + v[i][3];
#pragma unroll
            for (int o = 32; o >= 1; o >>= 1) s += __shfl_xor(s, o);
            const float mean = s * (1.0f / DM);
            float q = 0.f;
#pragma unroll
            for (int i = 0; i < 4; ++i) { v[i] -= mean; q += v[i][0] * v[i][0] + v[i][1] * v[i][1] + v[i][2] * v[i][2] + v[i][3] * v[i][3]; }
#pragma unroll
            for (int o = 32; o >= 1; o >>= 1) q += __shfl_xor(q, o);
            const float rstd = rsqrtf(q * (1.0f / DM) + LN_EPS);
#pragma unroll
            for (int i = 0; i < 4; ++i) v[i] = v[i] * rstd * w4[i] + b4[i];
        }
        if (final_) {
            if (row < NLAT) {
#pragma unroll
                for (int i = 0; i < 4; ++i) ((f32x4*)(p.out + (size_t)row * DM))[lane + 64 * i] = v[i];
            }
        } else {
            const float* shp = ada_l + cond * 6144 + sh_idx * 1024;
#pragma unroll
            for (int i = 0; i < 4; ++i) {
                ((f32x4*)(X + (size_t)row * DM))[lane + 64 * i] = v[i];
                const f32x4 sh = ((const f32x4*)shp)[lane + 64 * i], scl = ((const f32x4*)(shp + 1024))[lane + 64 * i];
                const f32x4 h = v[i] * (scl + 1.0f) + sh;
                u32x2 w; w.x = cvt_pk_bf16(h[0], h[1]); w.y = cvt_pk_bf16(h[2], h[3]);
                ((u32x2*)(H + (size_t)row * DM))[lane + 64 * i] = w;
            }
        }
    }
}

__device__ __forceinline__ void phase_localkv(const Params& p, int l, unsigned char* lds_g) {
    const int bid_ = launder_s(blockIdx.x);
    bf16_t* Kf = (bf16_t*)lds_g; bf16_t* Kb = Kf + 64 * 136; bf16_t* Vt = Kb + 64 * 136;
    const int tid = launder_tid(), wave = tid >> 6, lane = tid & 63, fr = lane & 15, fq = lane >> 4;
    const bf16_t* QKVG = (const bf16_t*)(p.ws + OFF_R + R_QKVG);
    float* KV = (float*)(p.ws + OFF_R + R_KV);
    for (int item = bid_; item < NRC * 8; item += gridDim.x) {
        const int rc = item >> 3, h = item & 7;
        const float lf2 = -__expf(p.rate_f[l * 8 + h]) * LOG2E, lb2 = -__expf(p.rate_b[l * 8 + h]) * LOG2E;
        { const int j = tid >> 2, part = tid & 3;
          const bf16_t* kp = QKVG + (size_t)(rc * 128 + j) * 2048 + 512 + h * 64 + part * 16;
          const u32x4 k0 = *(const u32x4*)kp, k1 = *(const u32x4*)(kp + 8), v0 = *(const u32x4*)(kp + 512), v1 = *(const u32x4*)(kp + 520);
          const float wf = exp2f(lf2 * (float)(127 - j)), wb = exp2f(lb2 * (float)j);
          const unsigned kk[8] = {k0.x, k0.y, k0.z, k0.w, k1.x, k1.y, k1.z, k1.w};
          const unsigned vv[8] = {v0.x, v0.y, v0.z, v0.w, v1.x, v1.y, v1.z, v1.w};
#pragma unroll
          for (int e = 0; e < 8; ++e) {
              const float klo = bflo(kk[e]), khi = bfhi(kk[e]);
              const int d0 = part * 16 + 2 * e;
              Kf[d0 * 136 + j] = (bf16_t)f2bf(klo * wf); Kf[(d0 + 1) * 136 + j] = (bf16_t)f2bf(khi * wf);
              Kb[d0 * 136 + j] = (bf16_t)f2bf(klo * wb); Kb[(d0 + 1) * 136 + j] = (bf16_t)f2bf(khi * wb);
              Vt[d0 * 136 + j] = (bf16_t)(vv[e] & 0xffffu); Vt[(d0 + 1) * 136 + j] = (bf16_t)(vv[e] >> 16);
          } }
        __syncthreads();
        { const int dir = wave >> 2, vt = wave & 3;
          const bf16_t* Kd = dir ? Kb : Kf;
          bf16x8 a[4];
#pragma unroll
          for (int ks = 0; ks < 4; ++ks) a[ks] = *(const bf16x8*)(Vt + (vt * 16 + fr) * 136 + ks * 32 + fq * 8);
          float* KVp = KV + ((size_t)(dir * NRC + rc) * 8 + h) * 4096;
#pragma unroll
          for (int dt = 0; dt < 4; ++dt) {
              f32x4 acc = {0.f, 0.f, 0.f, 0.f};
#pragma unroll
              for (int ks = 0; ks < 4; ++ks) { const bf16x8 b = *(const bf16x8*)(Kd + (dt * 16 + fr) * 136 + ks * 32 + fq * 8); acc = __builtin_amdgcn_mfma_f32_16x16x32_bf16(a[ks], b, acc, 0, 0, 0); }
#pragma unroll
              for (int r = 0; r < 4; ++r) KVp[(vt * 16 + fq * 4 + r) * 64 + dt * 16 + fr] = acc[r];
          } }
        __syncthreads();
    }
}

__device__ __forceinline__ void phase_scan(const Params& p, int l) {
    const float* __restrict__ KV = (const float*)(p.ws + OFF_R + R_KV);
    bf16_t* __restrict__ ST = (bf16_t*)(p.ws + OFF_R + R_ST);
    for (int g = launder_s(blockIdx.x) * 512 + launder_tid(); g < 131072; g += gridDim.x * 512) {
        const int e = g & 4095, h = (g >> 12) & 7, b = (g >> 15) & 1, dir = g >> 16;
        const float lg = -__expf(dir ? p.rate_b[l * 8 + h] : p.rate_f[l * 8 + h]);
        const float decay = __expf(lg * 128.0f);
        float s = 0.f;
        float cur[13], nxt[13];
#define SCAN_IDX(step) ((((size_t)(dir * NRC + ((step) < 2 ? (256 + 2 * b + (dir ? 1 - (step) : (step))) : (128 * b + (dir ? 127 - ((step) - 2) : ((step) - 2))))) * 8 + h) << 12) + e)
#pragma unroll
        for (int i = 0; i < 13; ++i) cur[i] = KV[SCAN_IDX(i)];
        for (int bt = 0; bt < 10; ++bt) {
            if (bt < 9) {
#pragma unroll
                for (int i = 0; i < 13; ++i) nxt[i] = KV[SCAN_IDX((bt + 1) * 13 + i)];
            }
#pragma unroll
            for (int i = 0; i < 13; ++i) { ST[SCAN_IDX(bt * 13 + i)] = (bf16_t)f2bf(s); s = decay * s + cur[i]; }
#pragma unroll
            for (int i = 0; i < 13; ++i) cur[i] = nxt[i];
        }
#undef SCAN_IDX
    }
}

__device__ __forceinline__ void phase_retout(const Params& p, int l, int nitems, unsigned char* lds_g) {
    const int bid_ = launder_s(blockIdx.x);
    bf16_t* Qs = (bf16_t*)lds_g;
    bf16_t* Ks = Qs + 128 * 72;
    bf16_t* Vt = Ks + 128 * 72;
    bf16_t* Ps = Vt + 64 * 136;
    bf16_t* Sf = Ps + 128 * 136;
    bf16_t* Sb = Sf + 64 * 72;
    const int tid = launder_tid(), wave = tid >> 6, lane = tid & 63, fr = lane & 15, fq = lane >> 4;
    const bf16_t* QKVG = (const bf16_t*)(p.ws + OFF_R + R_QKVG);
    const bf16_t* ST = (const bf16_t*)(p.ws + OFF_R + R_ST);
    bf16_t* MIX = (bf16_t*)(p.ws + OFF_H);
    for (int item = bid_; item < nitems; item += gridDim.x) {
        const int rc = item >> 3, h = item & 7;
        const float lf2 = -__expf(p.rate_f[l * 8 + h]) * LOG2E, lb2 = -__expf(p.rate_b[l * 8 + h]) * LOG2E;
        { const int j = tid >> 2, part = tid & 3;
          const bf16_t* qp = QKVG + (size_t)(rc * 128 + j) * 2048 + h * 64 + part * 16;
          const u32x4 q0 = *(const u32x4*)qp, q1 = *(const u32x4*)(qp + 8), k0 = *(const u32x4*)(qp + 512), k1 = *(const u32x4*)(qp + 520);
          const u32x4 v0 = *(const u32x4*)(qp + 1024), v1 = *(const u32x4*)(qp + 1032);
          *(u32x4*)(Qs + j * 72 + part * 16) = q0; *(u32x4*)(Qs + j * 72 + part * 16 + 8) = q1;
          *(u32x4*)(Ks + j * 72 + part * 16) = k0; *(u32x4*)(Ks + j * 72 + part * 16 + 8) = k1;
          const unsigned vv[8] = {v0.x, v0.y, v0.z, v0.w, v1.x, v1.y, v1.z, v1.w};
#pragma unroll
          for (int e = 0; e < 8; ++e) { const int d0 = part * 16 + 2 * e; Vt[d0 * 136 + j] = (bf16_t)(vv[e] & 0xffffu); Vt[(d0 + 1) * 136 + j] = (bf16_t)(vv[e] >> 16); }
          const size_t so = ((size_t)rc * 8 + h) * 4096 + (size_t)tid * 8;
          const u32x4 sf = *(const u32x4*)(ST + so), sb = *(const u32x4*)(ST + (size_t)NRC * 8 * 4096 + so);
          *(u32x4*)(Sf + (tid >> 3) * 72 + (tid & 7) * 8) = sf; *(u32x4*)(Sb + (tid >> 3) * 72 + (tid & 7) * 8) = sb; }
        __syncthreads();
        const int i0 = wave * 16;
        bf16x8 qa[2];
#pragma unroll
        for (int ks = 0; ks < 2; ++ks) qa[ks] = *(const bf16x8*)(Qs + (i0 + fr) * 72 + ks * 32 + fq * 8);
#pragma unroll
        for (int jt = 0; jt < 8; ++jt) {
            f32x4 acc = {0.f, 0.f, 0.f, 0.f};
#pragma unroll
            for (int ks = 0; ks < 2; ++ks) { const bf16x8 kb = *(const bf16x8*)(Ks + (jt * 16 + fr) * 72 + ks * 32 + fq * 8); acc = __builtin_amdgcn_mfma_f32_16x16x32_bf16(qa[ks], kb, acc, 0, 0, 0); }
            const int j = jt * 16 + fr;
#pragma unroll
            for (int r = 0; r < 4; ++r) { const int i = i0 + fq * 4 + r; const int diff = i - j;
                const float mk = diff > 0 ? exp2f(lf2 * (float)diff) : (diff < 0 ? exp2f(lb2 * (float)(-diff)) : 2.0f);
                Ps[i * 136 + j] = (bf16_t)f2bf(acc[r] * mk); }
        }
        __syncthreads();
        bf16x8 pa[4];
#pragma unroll
        for (int ks = 0; ks < 4; ++ks) pa[ks] = *(const bf16x8*)(Ps + (i0 + fr) * 136 + ks * 32 + fq * 8);
        float o[4][4];
        float qdf[4], qdb[4];
#pragma unroll
        for (int r = 0; r < 4; ++r) { const int i = i0 + fq * 4 + r; qdf[r] = exp2f(lf2 * (float)(i + 1)); qdb[r] = exp2f(lb2 * (float)(128 - i)); }
#pragma unroll
        for (int vt = 0; vt < 4; ++vt) {
            f32x4 ao = {0.f, 0.f, 0.f, 0.f}, af = {0.f, 0.f, 0.f, 0.f}, ab = {0.f, 0.f, 0.f, 0.f};
#pragma unroll
            for (int ks = 0; ks < 4; ++ks) { const bf16x8 vb = *(const bf16x8*)(Vt + (vt * 16 + fr) * 136 + ks * 32 + fq * 8); ao = __builtin_amdgcn_mfma_f32_16x16x32_bf16(pa[ks], vb, ao, 0, 0, 0); }
#pragma unroll
            for (int ks = 0; ks < 2; ++ks) { const bf16x8 s1 = *(const bf16x8*)(Sf + (vt * 16 + fr) * 72 + ks * 32 + fq * 8); af = __builtin_amdgcn_mfma_f32_16x16x32_bf16(qa[ks], s1, af, 0, 0, 0);
                                             const bf16x8 s2 = *(const bf16x8*)(Sb + (vt * 16 + fr) * 72 + ks * 32 + fq * 8); ab = __builtin_amdgcn_mfma_f32_16x16x32_bf16(qa[ks], s2, ab, 0, 0, 0); }
#pragma unroll
            for (int r = 0; r < 4; ++r) o[vt][r] = ao[r] + qdf[r] * af[r] + qdb[r] * ab[r];
        }
#pragma unroll
        for (int r = 0; r < 4; ++r) {
            float s = o[0][r] + o[1][r] + o[2][r] + o[3][r];
            s += __shfl_xor(s, 1); s += __shfl_xor(s, 2); s += __shfl_xor(s, 4); s += __shfl_xor(s, 8);
            const float mean = s * (1.0f / 64.0f);
            float q = 0.f;
#pragma unroll
            for (int vt = 0; vt < 4; ++vt) { o[vt][r] -= mean; q += o[vt][r] * o[vt][r]; }
            q += __shfl_xor(q, 1); q += __shfl_xor(q, 2); q += __shfl_xor(q, 4); q += __shfl_xor(q, 8);
            const float rstd = rsqrtf(q * (1.0f / 64.0f) + LN_EPS);
            const int row = rc * 128 + i0 + fq * 4 + r;
#pragma unroll
            for (int vt = 0; vt < 4; ++vt) {
                const int col = h * 64 + vt * 16 + fr;
                float y = o[vt][r] * rstd * p.gn_w[l * 512 + col] + p.gn_b[l * 512 + col];
                y = bf2f(f2bf(y));
                const float g = bf2f((unsigned)QKVG[(size_t)row * 2048 + 1536 + col]);
                MIX[(size_t)row * DM + col] = (bf16_t)f2bf(g * sigmoidf_(g) * y);
            }
        }
        __syncthreads();
    }
}

__device__ __forceinline__ void phase_conv(const Params& p, int l, int nitems, unsigned char* lds_g) {
    const int bid_ = launder_s(blockIdx.x);
    float* tile = (float*)lds_g;
    float* stat = tile + 32 * 512;
    const int tid = launder_tid(), wave = tid >> 6, lane = tid & 63;
    const bf16_t* U = (const bf16_t*)(p.ws + OFF_R + R_U);
    bf16_t* MIX = (bf16_t*)(p.ws + OFF_H);
    float w[31];
#pragma unroll
    for (int k = 0; k < 31; ++k) w[k] = p.conv_w[((size_t)l * 31 + k) * 512 + tid];
    const float cb = p.conv_b[l * 512 + tid], lw = p.cln_w[l * 512 + tid], lb = p.cln_b[l * 512 + tid];
    for (int item = bid_; item < nitems; item += gridDim.x) {
        const int t0 = item * 32;
        int lo, hi;
        if (t0 < NLAT) { lo = t0 & ~(SEQL - 1); hi = lo + SEQL; } else { lo = NLAT + ((t0 - NLAT) & ~255); hi = lo + 256; }
        float acc[32];
#pragma unroll
        for (int t = 0; t < 32; ++t) acc[t] = cb;
#pragma unroll
        for (int r = 0; r < 62; ++r) {
            const int row = t0 - 15 + r;
            float val = 0.f;
            if (row >= lo && row < hi) val = bf2f((unsigned)U[(size_t)row * 512 + tid]);
#pragma unroll
            for (int t = 0; t < 32; ++t) { const int k = r - t; if (k >= 0 && k <= 30) acc[t] += val * w[k]; }
        }
#pragma unroll
        for (int t = 0; t < 32; ++t) tile[t * 512 + tid] = acc[t];
        __syncthreads();
#pragma unroll
        for (int tt = 0; tt < 4; ++tt) {
            const int t = wave * 4 + tt;
            float v[8]; float s = 0.f;
#pragma unroll
            for (int i = 0; i < 8; ++i) { v[i] = tile[t * 512 + lane + 64 * i]; s += v[i]; }
#pragma unroll
            for (int o = 32; o >= 1; o >>= 1) s += __shfl_xor(s, o);
            const float mean = s * (1.0f / 512.0f);
            float q = 0.f;
#pragma unroll
            for (int i = 0; i < 8; ++i) { const float d = v[i] - mean; q += d * d; }
#pragma unroll
            for (int o = 32; o >= 1; o >>= 1) q += __shfl_xor(q, o);
            if (lane == 0) { stat[2 * t] = mean; stat[2 * t + 1] = rsqrtf(q * (1.0f / 512.0f) + LN_EPS); }
        }
        __syncthreads();
#pragma unroll
        for (int t = 0; t < 32; ++t) {
            const float y = (acc[t] - stat[2 * t]) * stat[2 * t + 1] * lw + lb;
            MIX[(size_t)(t0 + t) * DM + 512 + tid] = (bf16_t)f2bf(y * sigmoidf_(y));
        }
        __syncthreads();
    }
}

#define XB_TMO      128
#define XB_XCNT(j)  (256  + 64 * (j))
#define XB_XSUB(j)  (1280 + 64 * (j))
#define XB_XGEN(j)  (2304 + 64 * (j))
#define XB_TOP      3328
#define XB_TOPGEN   3392
#define XB_SPIN_CAP (1u << 20)
__device__ __forceinline__ unsigned xb_ld(unsigned* p)              { return __hip_atomic_load(p, __ATOMIC_RELAXED, __HIP_MEMORY_SCOPE_AGENT); }
__device__ __forceinline__ unsigned xb_add(unsigned* p, unsigned v) { return __hip_atomic_fetch_add(p, v, __ATOMIC_RELAXED, __HIP_MEMORY_SCOPE_AGENT); }
__device__ __forceinline__ unsigned xb_xcc_id() { return (unsigned)__builtin_amdgcn_s_getreg((3 << 11) | 20) & 0xFu; }
#define XB_SPIN(cond, bar) do { unsigned _sp = 0; while (cond) { __builtin_amdgcn_s_sleep(1); \
    if ((++_sp & 255u) == 0u) { if (xb_ld(&(bar)[XB_TMO])) break; if (_sp > XB_SPIN_CAP) { atomicAdd(&(bar)[XB_TMO], 1u); break; } } } } while (0)
struct XcdBarrier { unsigned* bar; unsigned x; volatile LAS unsigned* st; };
__device__ __forceinline__ XcdBarrier xcd_barrier_post(unsigned* bar, volatile LAS unsigned* st) {
    XcdBarrier b; b.bar = bar; b.x = xb_xcc_id(); b.st = st;
    if (threadIdx.x == 0) (void)xb_add(&bar[XB_XCNT(b.x)], 1u);
    return b;
}
__device__ __forceinline__ void xcd_barrier_complete(unsigned* bar, unsigned x, unsigned& nloc, unsigned& nx) {
    const unsigned G = gridDim.x * gridDim.y * gridDim.z;
    unsigned sum, cnt, mine, sp = 0u;
    for (;;) {
        sum = 0u; cnt = 0u; mine = 0u;
#pragma unroll
        for (unsigned j = 0; j < 16; ++j) { const unsigned c = xb_ld(&bar[XB_XCNT(j)]); sum += c; cnt += (c > 0u) ? 1u : 0u; mine = (j == x) ? c : mine; }
        if (sum == G) break;
        __builtin_amdgcn_s_sleep(1);
        if ((++sp & 255u) == 0u) { if (xb_ld(&bar[XB_TMO])) break; if (sp > XB_SPIN_CAP) { atomicAdd(&bar[XB_TMO], 1u); break; } }
    }
    nloc = mine > 0u ? mine : 1u; nx = cnt > 0u ? cnt : 1u;
}
__device__ __forceinline__ void xcd_barrier(const XcdBarrier& b) {
    asm volatile("s_waitcnt vmcnt(0)" ::: "memory");
    __syncthreads();
    if (threadIdx.x == 0) {
        unsigned* bar = b.bar;
        __builtin_amdgcn_s_waitcnt(0);
        unsigned nloc = b.st[0], nx = b.st[1];
        if (nloc == 0u) { xcd_barrier_complete(bar, b.x, nloc, nx); b.st[0] = nloc; b.st[1] = nx; }
        const unsigned old = xb_add(&bar[XB_XSUB(b.x)], 1u);
        const unsigned gen = old / nloc;
        if (old + 1u == (gen + 1u) * nloc) {
            __builtin_amdgcn_fence(__ATOMIC_RELEASE, "agent");
            asm volatile("s_waitcnt vmcnt(0)" ::: "memory");
            const unsigned og = xb_add(&bar[XB_TOP], 1u);
            const unsigned tg = og / nx;
            if (og + 1u == (tg + 1u) * nx) xb_add(&bar[XB_TOPGEN], 1u);
            else XB_SPIN(xb_ld(&bar[XB_TOPGEN]) == tg, bar);
            __builtin_amdgcn_fence(__ATOMIC_ACQUIRE, "agent");
            xb_add(&bar[XB_XGEN(b.x)], 1u);
            asm volatile("s_waitcnt vmcnt(0)" ::: "memory");
        } else {
            XB_SPIN(xb_ld(&bar[XB_XGEN(b.x)]) == gen, bar);
            __builtin_amdgcn_fence(__ATOMIC_ACQUIRE, "agent");
            asm volatile("s_waitcnt vmcnt(0)" ::: "memory");
        }
    }
    __syncthreads();
}

#ifndef REP_G
#define REP_G 1
#endif
#ifndef REP_N
#define REP_N 1
#endif
#ifndef REP_S
#define REP_S 1
#endif
#define GSYNC() do { for (int r_ = 0; r_ < REP_S; ++r_) xcd_barrier(xbar); } while (0)
__global__ void __launch_bounds__(512, 2) fwd_megakernel(Params p) {
    extern __shared__ __attribute__((aligned(16))) unsigned char lds[];
    cg::grid_group grid = cg::this_grid();
    LAS unsigned char* ldsl = (LAS unsigned char*)lds;
    const int G = gridDim.x;
    if (threadIdx.x < 16) ((volatile LAS unsigned*)(ldsl + 131072))[threadIdx.x] = 0u;
    __syncthreads();
    const XcdBarrier xbar = xcd_barrier_post((unsigned*)(p.ws + OFF_CTL), (volatile LAS unsigned*)(ldsl + 131072));
    float* X = (float*)(p.ws + OFF_X);
    bf16_t* H = (bf16_t*)(p.ws + OFF_H);
    const float* ADA = (const float*)(p.ws + OFF_ADA);
    bf16_t* WIN = (bf16_t*)(p.ws + OFF_WIN); bf16_t* WOUT = (bf16_t*)(p.ws + OFF_WOUT); bf16_t* WFF1 = (bf16_t*)(p.ws + OFF_WFF1); bf16_t* WFF2 = (bf16_t*)(p.ws + OFF_WFF2);
    bf16_t* QKVG = (bf16_t*)(p.ws + OFF_R + R_QKVG); bf16_t* U = (bf16_t*)(p.ws + OFF_R + R_U); bf16_t* HM = (bf16_t*)(p.ws + OFF_R);

    phase_adaln_rope(p, lds);
    convert_weights(p, 0, lds);
    grid.sync();
    row_pass(p, MTOT, nullptr, nullptr, ADA, 0, true, false);
    GSYNC();

    for (int l = 0; l < DEPTH; ++l) {
        const bool last = (l == DEPTH - 1);
        const int Ml = last ? NLAT : MTOT;
        const float* ada_l = ADA + (size_t)l * 3 * 6144;
        for (int r_ = 0; r_ < REP_G; ++r_) {
            pg8::Gemm g{H, WIN, MTOT, INW, DM}; pg8::StaticOrder S; S.init(MTOT, INW, G, launder_s(blockIdx.x));
            EpiInProj E{QKVG, U, (const float*)(p.ws + OFF_ROPE), last ? 1 : 0};
            pg8::gemm_phase<EpiInProj>(ldsl, g, S, E);
        }
        GSYNC();
        for (int r_ = 0; r_ < REP_N; ++r_) { phase_localkv(p, l, lds);
        phase_conv(p, l, Ml / 32, lds); }
        GSYNC();
        for (int r_ = 0; r_ < REP_N; ++r_) phase_scan(p, l);
        GSYNC();
        for (int r_ = 0; r_ < REP_N; ++r_) phase_retout(p, l, (Ml / 128) * 8, lds);
        GSYNC();
        {
            pg8::Gemm g{H, WOUT, Ml, DM, DM}; pg8::StaticOrder S; S.init(Ml, DM, G, launder_s(blockIdx.x));
            EpiRes E{X, ada_l + 2 * 1024};
            pg8::gemm_phase<EpiRes>(ldsl, g, S, E);
        }
        GSYNC();
        row_pass(p, Ml, p.ln1_w + l * DM, p.ln1_b + l * DM, ada_l, 3, false, false);
        GSYNC();
        for (int r_ = 0; r_ < REP_G; ++r_) {
            pg8::Gemm g{H, WFF1, Ml, DFF, DM}; pg8::StaticOrder S; S.init(Ml, DFF, G, launder_s(blockIdx.x));
            EpiFF1 E{HM};
            pg8::gemm_phase<EpiFF1>(ldsl, g, S, E);
        }
        GSYNC();
        {
            pg8::Gemm g{HM, WFF2, Ml, DM, DFF}; pg8::StaticOrder S; S.init(Ml, DM, G, launder_s(blockIdx.x));
            EpiRes E{X, ada_l + 5 * 1024};
            pg8::gemm_phase<EpiRes>(ldsl, g, S, E);
        }
        GSYNC();
        if (!last) {
            row_pass(p, MTOT, p.ln2_w + l * DM, p.ln2_b + l * DM, ada_l + 3 * 6144, 0, false, false);
            convert_weights(p, l + 1, lds);
            GSYNC();
        } else {
            row_pass(p, NLAT, p.ln2_w + l * DM, p.ln2_b + l * DM, ada_l, 0, false, true);
        }
    }
}

extern "C" void kernel_launch(void* const* d_in, const int* in_sizes, int n_in, void* d_out, int out_size, void* d_ws, size_t ws_size, hipStream_t stream) {
    static int grid_blocks = 0;
    if (grid_blocks == 0) {
        if (n_in != 22 || ws_size < WS_NEED) { fprintf(stderr, "kernel_launch: need 22 inputs and %zu bytes of workspace (got %d, %zu)\n", (size_t)WS_NEED, n_in, ws_size); grid_blocks = -1; return; }
        int dev = 0, cus = 0, per_cu = 0;
        hipGetDevice(&dev);
        hipDeviceGetAttribute(&cus, hipDeviceAttributeMultiprocessorCount, dev);
        hipFuncSetAttribute((const void*)fwd_megakernel, hipFuncAttributeMaxDynamicSharedMemorySize, LDS_BYTES);
        hipOccupancyMaxActiveBlocksPerMultiprocessor(&per_cu, (const void*)fwd_megakernel, 512, LDS_BYTES);
        if (per_cu < 1) { fprintf(stderr, "kernel_launch: occupancy query says %d blocks per CU\n", per_cu); per_cu = 1; }
        (void)hipGetLastError();
        grid_blocks = cus * 1;
    }
    if (grid_blocks < 0) return;
    if (hipMemsetAsync((char*)d_ws + OFF_CTL, 0, CTL_BYTES, stream) != hipSuccess) { fprintf(stderr, "kernel_launch: memset of barrier words failed\n"); return; }
    Params p{};
    const float** pp = (const float**)&p;
    for (int i = 0; i < 22; ++i) pp[i] = (const float*)d_in[i];
    p.out = (float*)d_out; p.ws = (unsigned char*)d_ws;
    void* args[] = {&p};
    hipError_t e = hipLaunchCooperativeKernel((const void*)fwd_megakernel, dim3(grid_blocks), dim3(512), args, LDS_BYTES, stream);
    if (e != hipSuccess) fprintf(stderr, "cooperative launch failed: %s (grid %d)\n", hipGetErrorString(e), grid_blocks);
}
```

```cpp
#include <hip/hip_runtime.h>
#include <hip/hip_cooperative_groups.h>
#include <cstdio>
#include <utility>
namespace cg = cooperative_groups;

#define LAS __attribute__((address_space(3)))
typedef unsigned short bf16_t;
typedef short bf16x8 __attribute__((ext_vector_type(8)));
typedef float f32x4 __attribute__((ext_vector_type(4)));
typedef unsigned u32x4 __attribute__((ext_vector_type(4)));
typedef unsigned u32x2 __attribute__((ext_vector_type(2)));

constexpr int DM = 1024, NLAT = 32768, MTOT = 33280, SEQL = 16384, DEPTH = 4;
constexpr int INW = 3072, DFF = 4096, NRC = 260  ;
constexpr float LN_EPS = 1e-5f;
constexpr float ALPHA = 1.681792830507429f;
constexpr float LOG2E = 1.4426950408889634f;

constexpr size_t OFF_WIN = 0;
constexpr size_t OFF_WOUT = OFF_WIN + (size_t)INW * DM * 2;
constexpr size_t OFF_WFF1 = OFF_WOUT + (size_t)DM * DM * 2;
constexpr size_t OFF_WFF2 = OFF_WFF1 + (size_t)DFF * DM * 2;
constexpr size_t OFF_ADA = OFF_WFF2 + (size_t)DFF * DM * 2;
constexpr size_t OFF_ROPE = OFF_ADA + (size_t)DEPTH * 3 * 6144 * 4;
constexpr size_t OFF_X = OFF_ROPE + 256 * 16 * 8;
constexpr size_t OFF_H = OFF_X + (size_t)MTOT * DM * 4;
constexpr size_t OFF_R = OFF_H + (size_t)MTOT * DM * 2;
constexpr size_t SEC_B = (size_t)MTOT * 512 * 2;
constexpr size_t R_Q = 0, R_K = SEC_B, R_G = 2 * SEC_B, R_KT = 3 * SEC_B, R_VT = 4 * SEC_B;
constexpr size_t R_U = 5 * SEC_B;
constexpr size_t R_KV = R_U + (size_t)MTOT * 512 * 2;
constexpr size_t R_ST = R_KV + (size_t)2 * NRC * 8 * 4096 * 4;
constexpr size_t R_END = R_ST + (size_t)2 * NRC * 8 * 4096 * 2;
constexpr size_t HM_BYTES = (size_t)MTOT * DFF * 2;
constexpr size_t WS_END = OFF_R + (R_END > HM_BYTES ? R_END : HM_BYTES);
constexpr size_t OFF_CTL = (WS_END + 255) / 256 * 256;
constexpr int XCD_BAR_WORDS_C = 3456;
constexpr size_t CTL_BYTES = (size_t)XCD_BAR_WORDS_C * 4;
constexpr size_t WS_NEED = OFF_CTL + CTL_BYTES;
constexpr int LDS_CTL = 2 * 72704;
constexpr int LDS_BYTES = LDS_CTL + 64;

struct Params {
    const float *x, *c, *ctx, *c_ctx, *w_ada, *b_ada, *w_in, *rate_f, *rate_b, *gn_w, *gn_b, *conv_w, *conv_b, *cln_w, *cln_b, *w_out,
        *ln1_w, *ln1_b, *w_ff1, *w_ff2, *ln2_w, *ln2_b;
    float* out;
    unsigned char* ws;
};

__device__ __forceinline__ unsigned f2bf(float f) { unsigned u = __builtin_bit_cast(unsigned, f); return (u + 0x7fffu + ((u >> 16) & 1u)) >> 16; }
__device__ __forceinline__ float bf2f(unsigned b) { return __builtin_bit_cast(float, b << 16); }
__device__ __forceinline__ float bflo(unsigned u) { return __builtin_bit_cast(float, u << 16); }
__device__ __forceinline__ float bfhi(unsigned u) { return __builtin_bit_cast(float, u & 0xffff0000u); }
__device__ __forceinline__ unsigned cvt_pk_bf16(float lo, float hi) { unsigned r; asm volatile("v_cvt_pk_bf16_f32 %0, %1, %2" : "=v"(r) : "v"(lo), "v"(hi)); return r; }
__device__ __forceinline__ int launder_tid() { int t = threadIdx.x; asm volatile("" : "+v"(t)); return t; }
__device__ __forceinline__ int launder_s(int v) { asm volatile("" : "+s"(v)); return v; }
template <class T> __device__ __forceinline__ T* launder_p(T* q) { asm volatile("" : "+s"(q)); return q; }
__device__ __forceinline__ float sigmoidf_(float v) { return 1.0f / (1.0f + __expf(-v)); }

namespace pg8 {
constexpr int BM = 256, BK = 64, HALF = 128, HTB = HALF * BK * 2, STAGE_BYTES = 8 * HTB, NXCD = 8, WGM = 8;
__host__ __device__ __forceinline__ int lds_byte(int r, int c) { const int st = (r >> 4) * 2 + (c >> 5), rr = r & 15, cc = c & 31, ob = rr * 64 + cc * 2; return st * 1024 + (ob ^ (((ob >> 9) & 1) << 5)); }
__host__ __device__ __forceinline__ void stage_rc(int b, int& R, int& C) { const int st = b / 1024, sb = b % 1024, swz = sb ^ (((sb >> 9) & 1) << 5); R = (st >> 1) * 16 + swz / 64; C = (st & 1) * 32 + (swz % 64) / 2; }
__host__ __device__ __forceinline__ int perm32(int rho) { const int n = rho >> 4, i = rho & 15; return 8 * (i >> 2) + 4 * n + (i & 3); }

struct Unit { int pm, pn; };
struct Gemm { const bf16_t* A; const bf16_t* Bt; int M, N, K; };

struct StaticOrder {
    int nM, nN, nwg, G, c;
    __device__ void init(int M, int N, int G_, int c_) { nM = M / BM; nN = N / BM; nwg = nM * nN; G = G_; c = c_; }
    __device__ bool next(int i, Unit& u) const {
        const long L = (long)i * G + c; if (L >= nwg) return false;
        int wgid = (int)L; { const int q = nwg / NXCD, r = nwg % NXCD, xcd = wgid % NXCD, off = wgid / NXCD; wgid = (xcd < r ? xcd * (q + 1) : r * (q + 1) + (xcd - r) * q) + off; }
        const int nig = WGM * nN, gid = wgid / nig, fm = gid * WGM, gsz = (nM - fm) < WGM ? (nM - fm) : WGM;
        u.pm = fm + ((wgid % nig) % gsz); u.pn = (wgid % nig) / gsz; return true;
    }
};

template <class Epi>
__device__ __forceinline__ void gemm_phase(LAS unsigned char* lds, const Gemm g, const StaticOrder& S, const Epi& E) {
    const int tid = launder_tid(), wid = __builtin_amdgcn_readfirstlane(tid >> 6), lane = tid & 63, wr = wid >> 2, wc = wid & 3, fr = lane & 15, fq = lane >> 4;
    const int K = g.K, nt = K / BK;
    unsigned voffA[2], voffB[2];
#pragma unroll
    for (int i = 0; i < 2; ++i) { int R, C; stage_rc(tid * 16 + i * 8192, R, C); const int Rb = Epi::PERM ? ((R & ~31) + perm32(R & 31)) : R;
        voffA[i] = (unsigned)(R * K + C) * 2u; voffB[i] = (unsigned)(Rb * K + C) * 2u; }
    const size_t kstep = (size_t)(BK * 2);
    const size_t hstep = (size_t)HALF * K * 2;
    const size_t tstep = 2 * hstep;
    const unsigned ldsw = (unsigned)wid * 1024u;
    const int aoff = lds_byte(wr * 64 + fr, fq * 8), boff = lds_byte(wc * 32 + fr, fq * 8);
#define PG8_SA(b, h) (((b) * 2 + (h)) * HTB)
#define PG8_SB(b, h) ((4 + (b) * 2 + (h)) * HTB)
#define PG8_STAGE(bufoff, gbase, voff) do { _Pragma("unroll") for (int _i = 0; _i < 2; ++_i) \
        __builtin_amdgcn_global_load_lds((const unsigned*)((const char*)(gbase) + (voff)[_i]), (LAS unsigned*)(lds + (bufoff) + ldsw + _i * 8192), 16, 0, 0); } while (0)
#define PG8_LDA(dst, b, h) do { _Pragma("unroll") for (int m = 0; m < 4; ++m) _Pragma("unroll") for (int k = 0; k < 2; ++k) dst[m][k] = *(const LAS bf16x8*)(lds + PG8_SA(b, h) + aoff + m * 2048 + k * 1024); } while (0)
#define PG8_LDB(dst, b, h) do { _Pragma("unroll") for (int n = 0; n < 2; ++n) _Pragma("unroll") for (int k = 0; k < 2; ++k) dst[n][k] = *(const LAS bf16x8*)(lds + PG8_SB(b, h) + boff + n * 2048 + k * 1024); } while (0)
#define PG8_MMA(ai, bj, At, Bt) do { __builtin_amdgcn_s_setprio(1); _Pragma("unroll") for (int m = 0; m < 4; ++m) _Pragma("unroll") for (int n = 0; n < 2; ++n) _Pragma("unroll") for (int k = 0; k < 2; ++k) \
        acc[ai][bj][m][n] = __builtin_amdgcn_mfma_f32_16x16x32_bf16(Bt[n][k], At[m][k], acc[ai][bj][m][n], 0, 0, 0); __builtin_amdgcn_s_setprio(0); } while (0)
#define PG8_WAIT_V(n) asm volatile("s_waitcnt vmcnt(" #n ")" ::: "memory")
#define PG8_WAIT_L(n) asm volatile("s_waitcnt lgkmcnt(" #n ")" ::: "memory")
#define PG8_BAR __builtin_amdgcn_s_barrier()
#define PG8_SCHED __builtin_amdgcn_sched_barrier(0)
    Unit cur, nxt; int ui = 0;
    if (!S.next(0, cur)) return;
    f32x4 acc[2][2][4][2];
#pragma unroll
    for (int a = 0; a < 2; ++a)
#pragma unroll
        for (int b = 0; b < 2; ++b)
#pragma unroll
            for (int m = 0; m < 4; ++m)
#pragma unroll
                for (int n = 0; n < 2; ++n) acc[a][b][m][n] = (f32x4){0.f, 0.f, 0.f, 0.f};
    bf16x8 At[4][2], B0[2][2], B1[2][2];
    const char* cA = (const char*)g.A + (size_t)cur.pm * tstep; const char* cB = (const char*)g.Bt + (size_t)cur.pn * tstep;
    PG8_STAGE(PG8_SB(0, 0), cB, voffB); PG8_STAGE(PG8_SB(0, 1), cB + hstep, voffB); PG8_STAGE(PG8_SA(0, 0), cA, voffA); PG8_STAGE(PG8_SA(0, 1), cA + hstep, voffA);
    if (wr == 1) PG8_BAR;
    PG8_WAIT_V(2); PG8_BAR;
    PG8_STAGE(PG8_SB(1, 0), cB + kstep, voffB); PG8_STAGE(PG8_SA(1, 0), cA + kstep, voffA); PG8_STAGE(PG8_SB(1, 1), cB + hstep + kstep, voffB);
    PG8_WAIT_V(6); PG8_BAR;
    for (;;) {
        const bool has_next = S.next(ui + 1, nxt);
        const char* nA = has_next ? (const char*)g.A + (size_t)nxt.pm * tstep : cA; const char* nB = has_next ? (const char*)g.Bt + (size_t)nxt.pn * tstep : cB;
        for (int t = 0; t < nt; t += 2) {
            const bool last = (t == nt - 2);
            const char* a1 = cA + (size_t)(t + 1) * kstep;
            const char* a2 = last ? nA : cA + (size_t)(t + 2) * kstep; const char* b2 = last ? nB : cB + (size_t)(t + 2) * kstep;
            const char* a3 = a2 + kstep; const char* b3 = b2 + kstep;
            PG8_LDB(B0, 0, 0); PG8_LDB(B1, 0, 1); PG8_SCHED; PG8_LDA(At, 0, 0); PG8_STAGE(PG8_SA(1, 1), a1 + hstep, voffA);
            PG8_WAIT_V(8); PG8_WAIT_L(0); PG8_BAR; PG8_MMA(0, 0, At, B0); PG8_MMA(0, 1, At, B1); PG8_BAR; PG8_SCHED;
            PG8_LDA(At, 0, 1); PG8_STAGE(PG8_SB(0, 0), b2, voffB); PG8_STAGE(PG8_SB(0, 1), b2 + hstep, voffB); PG8_STAGE(PG8_SA(0, 0), a2, voffA);
            PG8_WAIT_V(8); PG8_WAIT_L(0); PG8_BAR; PG8_MMA(1, 0, At, B0); PG8_MMA(1, 1, At, B1); PG8_BAR; PG8_SCHED;
            PG8_LDB(B0, 1, 0); PG8_LDB(B1, 1, 1); PG8_SCHED; PG8_LDA(At, 1, 0); PG8_STAGE(PG8_SA(0, 1), a2 + hstep, voffA);
            PG8_WAIT_V(8); PG8_WAIT_L(0); PG8_BAR; PG8_MMA(0, 0, At, B0); PG8_MMA(0, 1, At, B1); PG8_BAR; PG8_SCHED;
            PG8_LDA(At, 1, 1); PG8_STAGE(PG8_SB(1, 0), b3, voffB); PG8_STAGE(PG8_SB(1, 1), b3 + hstep, voffB); PG8_STAGE(PG8_SA(1, 0), a3, voffA);
            PG8_WAIT_V(8); PG8_WAIT_L(0); PG8_BAR; PG8_MMA(1, 0, At, B0); PG8_MMA(1, 1, At, B1); PG8_BAR; PG8_SCHED;
        }
        if (wr == 0) PG8_BAR;
        E(acc, cur, wr, wc, fr, fq);
        if (!has_next) break;
#pragma unroll
        for (int a = 0; a < 2; ++a)
#pragma unroll
            for (int b = 0; b < 2; ++b)
#pragma unroll
                for (int m = 0; m < 4; ++m)
#pragma unroll
                    for (int n = 0; n < 2; ++n) acc[a][b][m][n] = (f32x4){0.f, 0.f, 0.f, 0.f};
        cur = nxt; cA = nA; cB = nB; ++ui;
        if (wr == 1) PG8_BAR;
    }
    PG8_WAIT_V(0);
    PG8_BAR;
#undef PG8_SA
#undef PG8_SB
#undef PG8_STAGE
#undef PG8_LDA
#undef PG8_LDB
#undef PG8_MMA
#undef PG8_WAIT_V
#undef PG8_WAIT_L
#undef PG8_BAR
#undef PG8_SCHED
}
}

struct EpiInProj {
    static constexpr bool PERM = true;
    bf16_t *R, *U; const float* rope; int last;
    __device__ __forceinline__ void operator()(const f32x4 (&acc)[2][2][4][2], const pg8::Unit& u, int wr, int wc, int fr, int fq) const {
        const int row0 = u.pm * 256 + wr * 64 + fr;
        const bool is_ctx = u.pm >= 128;
        if (u.pn < 8) {
            const int sect = u.pn >> 1;
            const int colb = (u.pn & 1) * 256 + wc * 32 + 8 * fq;
            const bool do_rope = (sect < 2) && !is_ctx;
            const float kscale = (sect == 1 && !(is_ctx && last)) ? 0.125f : 1.0f;
            bf16_t* nat = R + (size_t)(sect == 3 ? 2 : sect) * ((size_t)MTOT * 512);
            bf16_t* tr = R + (size_t)(sect + 2) * ((size_t)MTOT * 512);
            const bool odd = fr & 1;
#pragma unroll
            for (int ai = 0; ai < 2; ++ai)
#pragma unroll
                for (int m = 0; m < 4; ++m) {
                    const int row = row0 + ai * 128 + m * 16;
                    f32x4 cs0 = {1.f, 0.f, 1.f, 0.f}, cs1 = {1.f, 0.f, 1.f, 0.f};
                    if (do_rope) { const int pos = (wc & 1) ? (row & 63) : ((row & (SEQL - 1)) >> 6);
                        const f32x4* rp = (const f32x4*)(rope + (size_t)(pos * 16 + 4 * fq) * 2); cs0 = rp[0]; cs1 = rp[1]; }
#pragma unroll
                    for (int bj = 0; bj < 2; ++bj) {
                        f32x4 v0 = acc[ai][bj][m][0], v1 = acc[ai][bj][m][1];
                        if (do_rope) {
                            f32x4 w0, w1;
                            w0[0] = v0[0] * cs0[0] - v0[1] * cs0[1]; w0[1] = v0[0] * cs0[1] + v0[1] * cs0[0];
                            w0[2] = v0[2] * cs0[2] - v0[3] * cs0[3]; w0[3] = v0[2] * cs0[3] + v0[3] * cs0[2];
                            w1[0] = v1[0] * cs1[0] - v1[1] * cs1[1]; w1[1] = v1[0] * cs1[1] + v1[1] * cs1[0];
                            w1[2] = v1[2] * cs1[2] - v1[3] * cs1[3]; w1[3] = v1[2] * cs1[3] + v1[3] * cs1[2];
                            v0 = w0; v1 = w1;
                        }
                        v0 *= kscale; v1 *= kscale;
                        u32x4 w; w.x = cvt_pk_bf16(v0[0], v0[1]); w.y = cvt_pk_bf16(v0[2], v0[3]); w.z = cvt_pk_bf16(v1[0], v1[1]); w.w = cvt_pk_bf16(v1[2], v1[3]);
                        const int c = colb + bj * 128;
                        if (sect != 2) *(u32x4*)(nat + (size_t)row * 512 + c) = w;
                        if (sect == 1 || sect == 2) {
                            const unsigned send0 = odd ? w.x : w.z, send1 = odd ? w.y : w.w, keep0 = odd ? w.z : w.x, keep1 = odd ? w.w : w.y;
                            const unsigned recv0 = (unsigned)__builtin_amdgcn_mov_dpp((int)send0, 0xB1, 0xF, 0xF, true), recv1 = (unsigned)__builtin_amdgcn_mov_dpp((int)send1, 0xB1, 0xF, 0xF, true);
                            const unsigned lo0 = odd ? recv0 : keep0, hi0 = odd ? keep0 : recv0, lo1 = odd ? recv1 : keep1, hi1 = odd ? keep1 : recv1;
                            const unsigned o0 = (lo0 & 0xffffu) | (hi0 << 16), o1 = (lo0 >> 16) | (hi0 & 0xffff0000u), o2 = (lo1 & 0xffffu) | (hi1 << 16), o3 = (lo1 >> 16) | (hi1 & 0xffff0000u);
                            const int h = c >> 6, d = (c & 63) + (odd ? 4 : 0);
                            bf16_t* tp = tr + ((size_t)((row >> 7) * 8 + h) * 64 + d) * 128 + (row & 126);
                            *(unsigned*)(tp) = o0; *(unsigned*)(tp + 128) = o1; *(unsigned*)(tp + 256) = o2; *(unsigned*)(tp + 384) = o3;
                        }
                    }
                }
        } else {
            const int colb = (u.pn - 8) * 128 + wc * 32 + 8 * fq;
#pragma unroll
            for (int ai = 0; ai < 2; ++ai)
#pragma unroll
                for (int m = 0; m < 4; ++m) {
                    const int row = row0 + ai * 128 + m * 16;
                    f32x4 a0 = acc[ai][0][m][0], a1 = acc[ai][0][m][1], g0 = acc[ai][1][m][0], g1 = acc[ai][1][m][1];
#pragma unroll
                    for (int j = 0; j < 4; ++j) { a0[j] *= sigmoidf_(g0[j]); a1[j] *= sigmoidf_(g1[j]); }
                    u32x4 w; w.x = cvt_pk_bf16(a0[0], a0[1]); w.y = cvt_pk_bf16(a0[2], a0[3]); w.z = cvt_pk_bf16(a1[0], a1[1]); w.w = cvt_pk_bf16(a1[2], a1[3]);
                    *(u32x4*)(U + (size_t)row * 512 + colb) = w;
                }
        }
    }
};
struct EpiRes {
    static constexpr bool PERM = false;
    float* X; const float* gate;
    __device__ __forceinline__ void operator()(const f32x4 (&acc)[2][2][4][2], const pg8::Unit& u, int wr, int wc, int fr, int fq) const {
        const int row0 = u.pm * 256 + wr * 64 + fr, col0 = u.pn * 256 + wc * 32 + 4 * fq;
        const int cond = u.pm < 64 ? 0 : (u.pm < 128 ? 1 : 2);
        const float* gp = gate + cond * 6144 + col0;
        f32x4 gv[2][2];
#pragma unroll
        for (int bj = 0; bj < 2; ++bj)
#pragma unroll
            for (int n = 0; n < 2; ++n) gv[bj][n] = *(const f32x4*)(gp + bj * 128 + n * 16);
#pragma unroll
        for (int ai = 0; ai < 2; ++ai)
#pragma unroll
            for (int m = 0; m < 4; ++m) { float* rowp = X + (size_t)(row0 + ai * 128 + m * 16) * DM + col0;
#pragma unroll
                for (int bj = 0; bj < 2; ++bj)
#pragma unroll
                    for (int n = 0; n < 2; ++n) { f32x4 xv = *(const f32x4*)(rowp + bj * 128 + n * 16); xv = xv * ALPHA + gv[bj][n] * acc[ai][bj][m][n]; *(f32x4*)(rowp + bj * 128 + n * 16) = xv; } }
    }
};
struct EpiFF1 {
    static constexpr bool PERM = true;
    bf16_t* O;
    __device__ __forceinline__ void operator()(const f32x4 (&acc)[2][2][4][2], const pg8::Unit& u, int wr, int wc, int fr, int fq) const {
        const int row0 = u.pm * 256 + wr * 64 + fr, col0 = u.pn * 256 + wc * 32 + 8 * fq;
#pragma unroll
        for (int ai = 0; ai < 2; ++ai)
#pragma unroll
            for (int m = 0; m < 4; ++m) { bf16_t* rowp = O + (size_t)(row0 + ai * 128 + m * 16) * DFF + col0;
#pragma unroll
                for (int bj = 0; bj < 2; ++bj) { f32x4 v0 = acc[ai][bj][m][0], v1 = acc[ai][bj][m][1];
#pragma unroll
                    for (int j = 0; j < 4; ++j) { float a = fmaxf(v0[j], 0.f), b = fmaxf(v1[j], 0.f); v0[j] = a * a; v1[j] = b * b; }
                    u32x4 w; w.x = cvt_pk_bf16(v0[0], v0[1]); w.y = cvt_pk_bf16(v0[2], v0[3]); w.z = cvt_pk_bf16(v1[0], v1[1]); w.w = cvt_pk_bf16(v1[2], v1[3]);
                    *(u32x4*)(rowp + bj * 128) = w; } }
    }
};

__device__ __forceinline__ void convert_weights(const Params& p, int l, unsigned char* lds_g) {
    const int bid_ = launder_s(blockIdx.x);
    float* ls = (float*)lds_g;
    const int tid = launder_tid();
    for (int t = bid_; t < 3072; t += gridDim.x) {
        const float* W; bf16_t* Wt; int K, N, tt;
        if (t < 768) { W = p.w_in + (size_t)l * DM * INW; Wt = (bf16_t*)(p.ws + OFF_WIN); K = DM; N = INW; tt = t; }
        else if (t < 1024) { W = p.w_out + (size_t)l * DM * DM; Wt = (bf16_t*)(p.ws + OFF_WOUT); K = DM; N = DM; tt = t - 768; }
        else if (t < 2048) { W = p.w_ff1 + (size_t)l * DM * DFF; Wt = (bf16_t*)(p.ws + OFF_WFF1); K = DM; N = DFF; tt = t - 1024; }
        else { W = p.w_ff2 + (size_t)l * DFF * DM; Wt = (bf16_t*)(p.ws + OFF_WFF2); K = DFF; N = DM; tt = t - 2048; }
        const int ntn = N / 64, k0 = (tt / ntn) * 64, n0 = (tt % ntn) * 64;
#pragma unroll
        for (int i = 0; i < 8; ++i) { const int k = (tid >> 6) + 8 * i, n = tid & 63; ls[k * 65 + n] = W[(size_t)(k0 + k) * N + n0 + n]; }
        __syncthreads();
        { const int n = tid >> 3, kk = (tid & 7) * 8;
          float v[8];
#pragma unroll
          for (int j = 0; j < 8; ++j) v[j] = ls[(kk + j) * 65 + n];
          int nn = n0 + n;
          if (t < 768 && nn >= 2048) { const int isb = nn >= 2560; const int cc = nn - (isb ? 2560 : 2048); nn = 2048 + 256 * (cc >> 7) + 128 * isb + (cc & 127); }
          u32x4 w; w.x = cvt_pk_bf16(v[0], v[1]); w.y = cvt_pk_bf16(v[2], v[3]); w.z = cvt_pk_bf16(v[4], v[5]); w.w = cvt_pk_bf16(v[6], v[7]);
          *(u32x4*)(Wt + (size_t)nn * K + k0 + kk) = w; }
        __syncthreads();
    }
}

__device__ __forceinline__ void phase_adaln_rope(const Params& p, unsigned char* lds_g) {
    const int bid_ = launder_s(blockIdx.x);
    float* sc = (float*)lds_g;
    float* red = sc + 3 * 1024;
    const int tid = launder_tid(), wave = tid >> 6, lane = tid & 63;
    for (int e = bid_ * 512 + tid; e < 256 * 16; e += gridDim.x * 512) {
        const int pos = e >> 4, f = e & 15;
        const float inv = powf(10000.0f, -(float)f / 16.0f);
        const float angf = (float)pos * inv;
        double a = (double)angf;
        const double twopi = 6.283185307179586476925;
        a -= twopi * rint(a / twopi);
        const double a2 = a * a;
        double sn = 0.0, cn = 0.0, ts = a, tc = 1.0;
        for (int i = 0; i < 16; ++i) { cn += tc; sn += ts; tc = -tc * a2 / (double)((2 * i + 1) * (2 * i + 2)); ts = -ts * a2 / (double)((2 * i + 2) * (2 * i + 3)); }
        float* rp = (float*)(p.ws + OFF_ROPE);
        rp[2 * e] = (float)cn; rp[2 * e + 1] = (float)sn;
    }
    for (int i = tid; i < 3072; i += 512) { const float v = i < 2048 ? p.c[i] : p.c_ctx[i - 2048]; sc[i] = v * sigmoidf_(v); }
    __syncthreads();
    float* ADA = (float*)(p.ws + OFF_ADA);
    for (int item = bid_; item < DEPTH * 96; item += gridDim.x) {
        const int l = item / 96, n0 = (item % 96) * 64;
        const float* W = p.w_ada + (size_t)l * DM * 6144 + n0 + lane;
        float a0 = 0.f, a1 = 0.f, a2 = 0.f;
        const int kb = wave * 128;
#pragma unroll 8
        for (int k = 0; k < 128; ++k) { const float w = W[(size_t)(kb + k) * 6144]; a0 += sc[kb + k] * w; a1 += sc[1024 + kb + k] * w; a2 += sc[2048 + kb + k] * w; }
        red[(wave * 3 + 0) * 64 + lane] = a0; red[(wave * 3 + 1) * 64 + lane] = a1; red[(wave * 3 + 2) * 64 + lane] = a2;
        __syncthreads();
        if (tid < 192) { const int j = tid >> 6; float s = 0.f;
#pragma unroll
            for (int w = 0; w < 8; ++w) s += red[(w * 3 + j) * 64 + lane];
            ADA[(size_t)(l * 3 + j) * 6144 + n0 + lane] = s + p.b_ada[l * 6144 + n0 + lane]; }
        __syncthreads();
    }
}

__device__ __forceinline__ void row_pass(const Params& p, int nrows, const float* lnw, const float* lnb, const float* ada_l, int sh_idx, bool init, bool final_) {
    const int tid = launder_tid(), wave = tid >> 6, lane = tid & 63;
    float* X = (float*)(p.ws + OFF_X); bf16_t* H = (bf16_t*)(p.ws + OFF_H);
    f32x4 w4[4], b4[4];
    if (!init) {
#pragma unroll
        for (int i = 0; i < 4; ++i) { w4[i] = ((const f32x4*)lnw)[lane + 64 * i]; b4[i] = ((const f32x4*)lnb)[lane + 64 * i]; }
    }
    for (int row = launder_s(blockIdx.x) * 8 + wave; row < nrows; row += gridDim.x * 8) {
        const int cond = row < SEQL ? 0 : (row < NLAT ? 1 : 2);
        const float* src = init ? (row < NLAT ? p.x + (size_t)row * DM : p.ctx + (size_t)(row - NLAT) * DM) : X + (size_t)row * DM;
        f32x4 v[4];
#pragma unroll
        for (int i = 0; i < 4; ++i) v[i] = ((const f32x4*)src)[lane + 64 * i];
        if (!init) {
            float s = 0.f;
#pragma unroll
            for (int i = 0; i < 4; ++i) s += v[i][0] + v[i][1] + v[i][2] + v[i][3];
#pragma unroll
            for (int o = 32; o >= 1; o >>= 1) s += __shfl_xor(s, o);
            const float mean = s * (1.0f / DM);
            float q = 0.f;
#pragma unroll
            for (int i = 0; i < 4; ++i) { v[i] -= mean; q += v[i][0] * v[i][0] + v[i][1] * v[i][1] + v[i][2] * v[i][2] + v[i][3] * v[i][3]; }
#pragma unroll
            for (int o = 32; o >= 1; o >>= 1) q += __shfl_xor(q, o);
            const float rstd = rsqrtf(q * (1.0f / DM) + LN_EPS);
#pragma unroll
            for (int i = 0; i < 4; ++i) v[i] = v[i] * rstd * w4[i] + b4[i];
        }
        if (final_) {
            if (row < NLAT) {
#pragma unroll
                for (int i = 0; i < 4; ++i) ((f32x4*)(p.out + (size_t)row * DM))[lane + 64 * i] = v[i];
            }
        } else {
            const float* shp = ada_l + cond * 6144 + sh_idx * 1024;
#pragma unroll
            for (int i = 0; i < 4; ++i) {
                ((f32x4*)(X + (size_t)row * DM))[lane + 64 * i] = v[i];
                const f32x4 sh = ((const f32x4*)shp)[lane + 64 * i], scl = ((const f32x4*)(shp + 1024))[lane + 64 * i];
                const f32x4 h = v[i] * (scl + 1.0f) + sh;
                u32x2 w; w.x = cvt_pk_bf16(h[0], h[1]); w.y = cvt_pk_bf16(h[2], h[3]);
                ((u32x2*)(H + (size_t)row * DM))[lane + 64 * i] = w;
            }
        }
    }
}

__device__ __forceinline__ void phase_localkv(const Params& p, int l) {
    const int bid_ = launder_s(blockIdx.x);
    const int tid = launder_tid(), wave = tid >> 6, lane = tid & 63, fr = lane & 15, fq = lane >> 4;
    const bf16_t* KT = (const bf16_t*)(p.ws + OFF_R + R_KT);
    const bf16_t* VT = (const bf16_t*)(p.ws + OFF_R + R_VT);
    float* KV = (float*)(p.ws + OFF_R + R_KV);
    const int dir = wave >> 2, vt = wave & 3;
    for (int item = bid_; item < NRC * 8; item += gridDim.x) {
        const int rc = item >> 3, h = item & 7;
        const float l2 = -__expf(dir ? p.rate_b[l * 8 + h] : p.rate_f[l * 8 + h]) * LOG2E;
        const bf16_t* vp = VT + ((size_t)item * 64 + vt * 16 + fr) * 128 + fq * 8;
        const bf16_t* kp = KT + ((size_t)item * 64 + fr) * 128 + fq * 8;
        bf16x8 vb[4];
#pragma unroll
        for (int ks = 0; ks < 4; ++ks) {
            const u32x4 raw = *(const u32x4*)(vp + ks * 32);
            const unsigned rr[4] = {raw.x, raw.y, raw.z, raw.w};
            u32x4 o;
            unsigned oo[4];
#pragma unroll
            for (int e = 0; e < 4; ++e) {
                const int j0 = ks * 32 + fq * 8 + 2 * e;
                const float w0 = exp2f(l2 * (float)(dir ? j0 : 127 - j0)), w1 = exp2f(l2 * (float)(dir ? j0 + 1 : 126 - j0));
                oo[e] = cvt_pk_bf16(bflo(rr[e]) * w0, bfhi(rr[e]) * w1);
            }
            o.x = oo[0]; o.y = oo[1]; o.z = oo[2]; o.w = oo[3];
            vb[ks] = __builtin_bit_cast(bf16x8, o);
        }
        float* KVp = KV + ((size_t)(dir * NRC + rc) * 8 + h) * 4096 + (vt * 16 + fr) * 64 + fq * 4;
#pragma unroll
        for (int dt = 0; dt < 4; ++dt) {
            f32x4 acc = {0.f, 0.f, 0.f, 0.f};
#pragma unroll
            for (int ks = 0; ks < 4; ++ks) { const bf16x8 ka = *(const bf16x8*)(kp + (size_t)dt * 16 * 128 + ks * 32); acc = __builtin_amdgcn_mfma_f32_16x16x32_bf16(ka, vb[ks], acc, 0, 0, 0); }
            *(f32x4*)(KVp + dt * 16) = acc;
        }
    }
}

__device__ __forceinline__ void phase_scan(const Params& p, int l) {
    const float* __restrict__ KV = (const float*)(p.ws + OFF_R + R_KV);
    bf16_t* __restrict__ ST = (bf16_t*)(p.ws + OFF_R + R_ST);
    for (int g = launder_s(blockIdx.x) * 512 + launder_tid(); g < 131072; g += gridDim.x * 512) {
        const int e = g & 4095, h = (g >> 12) & 7, b = (g >> 15) & 1, dir = g >> 16;
        const float lg = -__expf(dir ? p.rate_b[l * 8 + h] : p.rate_f[l * 8 + h]);
        const float decay = __expf(lg * 128.0f);
        float s = 0.f;
        float cur[13], nxt[13];
#define SCAN_IDX(step) ((((size_t)(dir * NRC + ((step) < 2 ? (256 + 2 * b + (dir ? 1 - (step) : (step))) : (128 * b + (dir ? 127 - ((step) - 2) : ((step) - 2))))) * 8 + h) << 12) + e)
#pragma unroll
        for (int i = 0; i < 13; ++i) cur[i] = KV[SCAN_IDX(i)];
        for (int bt = 0; bt < 10; ++bt) {
            if (bt < 9) {
#pragma unroll
                for (int i = 0; i < 13; ++i) nxt[i] = KV[SCAN_IDX((bt + 1) * 13 + i)];
            }
#pragma unroll
            for (int i = 0; i < 13; ++i) { ST[SCAN_IDX(bt * 13 + i)] = (bf16_t)f2bf(s); s = decay * s + cur[i]; }
#pragma unroll
            for (int i = 0; i < 13; ++i) cur[i] = nxt[i];
        }
#undef SCAN_IDX
    }
}

constexpr int RO_Q = 0, RO_K = 18432, RO_VT = 36864, RO_SF = 54272, RO_SB = 63488, RO_BUF = 72704;
__device__ __forceinline__ void phase_retout(const Params& p, int l, int nitems, unsigned char* lds_g) {
    const int bid_ = launder_s(blockIdx.x);
    const int tid = launder_tid(), wave = tid >> 6, lane = tid & 63, fr = lane & 15, fq = lane >> 4;
    const bf16_t* Qb = (const bf16_t*)(p.ws + OFF_R + R_Q);
    const bf16_t* Kb = (const bf16_t*)(p.ws + OFF_R + R_K);
    const bf16_t* Gb = (const bf16_t*)(p.ws + OFF_R + R_G);
    const bf16_t* VT = (const bf16_t*)(p.ws + OFF_R + R_VT);
    const bf16_t* ST = (const bf16_t*)(p.ws + OFF_R + R_ST);
    bf16_t* MIX = (bf16_t*)(p.ws + OFF_H);
    const int i0 = wave * 16;
    u32x4 pq0, pq1, pk0, pk1, pv0, pv1, psf, psb;
#define RO_LOAD(it) do { const int rc_ = (it) >> 3, h_ = (it) & 7; \
        const bf16_t* q_ = Qb + (size_t)(rc_ * 128 + (tid >> 3)) * 512 + h_ * 64 + (tid & 7) * 8; \
        pq0 = *(const u32x4*)q_; pq1 = *(const u32x4*)(q_ + 64 * 512); \
        const bf16_t* k_ = Kb + (size_t)(rc_ * 128 + (tid >> 3)) * 512 + h_ * 64 + (tid & 7) * 8; \
        pk0 = *(const u32x4*)k_; pk1 = *(const u32x4*)(k_ + 64 * 512); \
        const bf16_t* v_ = VT + ((size_t)(it) * 64 + (tid >> 4)) * 128 + (tid & 15) * 8; \
        pv0 = *(const u32x4*)v_; pv1 = *(const u32x4*)(v_ + 32 * 128); \
        const bf16_t* s_ = ST + (size_t)(it) * 4096 + (size_t)tid * 8; \
        psf = *(const u32x4*)s_; psb = *(const u32x4*)(s_ + (size_t)NRC * 8 * 4096); } while (0)
#define RO_STORE(buf) do { unsigned char* b_ = lds_g + (buf) * RO_BUF; \
        *(u32x4*)(b_ + RO_Q + (tid >> 3) * 144 + (tid & 7) * 16) = pq0; *(u32x4*)(b_ + RO_Q + ((tid >> 3) + 64) * 144 + (tid & 7) * 16) = pq1; \
        *(u32x4*)(b_ + RO_K + (tid >> 3) * 144 + (tid & 7) * 16) = pk0; *(u32x4*)(b_ + RO_K + ((tid >> 3) + 64) * 144 + (tid & 7) * 16) = pk1; \
        *(u32x4*)(b_ + RO_VT + (tid >> 4) * 272 + (tid & 15) * 16) = pv0; *(u32x4*)(b_ + RO_VT + ((tid >> 4) + 32) * 272 + (tid & 15) * 16) = pv1; \
        *(u32x4*)(b_ + RO_SF + (tid >> 3) * 144 + (tid & 7) * 16) = psf; *(u32x4*)(b_ + RO_SB + (tid >> 3) * 144 + (tid & 7) * 16) = psb; } while (0)
    int item = bid_;
    if (item < nitems) { RO_LOAD(item); RO_STORE(0); }
    __syncthreads();
    int cur = 0;
    for (; item < nitems; item += gridDim.x) {
        const int nxt = item + gridDim.x;
        if (nxt < nitems) RO_LOAD(nxt);
        const unsigned char* B = lds_g + cur * RO_BUF;
        const int rc = item >> 3, h = item & 7;
        const float lf2 = -__expf(p.rate_f[l * 8 + h]) * LOG2E, lb2 = -__expf(p.rate_b[l * 8 + h]) * LOG2E;
        const int i = i0 + fr;
        bf16x8 qb[2];
        qb[0] = *(const bf16x8*)(B + RO_Q + i * 144 + fq * 16); qb[1] = *(const bf16x8*)(B + RO_Q + i * 144 + 64 + fq * 16);
        const int jrow = 8 * (fr >> 2) + (fr & 3);
        bf16x8 pb[4];
#pragma unroll
        for (int s2 = 0; s2 < 4; ++s2) {
            f32x4 sa[2];
#pragma unroll
            for (int t2 = 0; t2 < 2; ++t2) {
                f32x4 acc = {0.f, 0.f, 0.f, 0.f};
                const unsigned char* kr = B + RO_K + (32 * s2 + jrow + 4 * t2) * 144 + fq * 16;
#pragma unroll
                for (int ks = 0; ks < 2; ++ks) { const bf16x8 ka = *(const bf16x8*)(kr + ks * 64); acc = __builtin_amdgcn_mfma_f32_16x16x32_bf16(ka, qb[ks], acc, 0, 0, 0); }
#pragma unroll
                for (int r = 0; r < 4; ++r) { const int j = 32 * s2 + 8 * fq + 4 * t2 + r; const int diff = i - j;
                    const float mk = diff > 0 ? exp2f(lf2 * (float)diff) : (diff < 0 ? exp2f(lb2 * (float)(-diff)) : 2.0f);
                    acc[r] *= mk; }
                sa[t2] = acc;
            }
            u32x4 o; o.x = cvt_pk_bf16(sa[0][0], sa[0][1]); o.y = cvt_pk_bf16(sa[0][2], sa[0][3]); o.z = cvt_pk_bf16(sa[1][0], sa[1][1]); o.w = cvt_pk_bf16(sa[1][2], sa[1][3]);
            pb[s2] = __builtin_bit_cast(bf16x8, o);
        }
        const float qdf = exp2f(lf2 * (float)(i + 1)), qdb = exp2f(lb2 * (float)(128 - i));
        float o[4][4];
#pragma unroll
        for (int vt = 0; vt < 4; ++vt) {
            f32x4 ao = {0.f, 0.f, 0.f, 0.f}, af = {0.f, 0.f, 0.f, 0.f}, ab = {0.f, 0.f, 0.f, 0.f};
#pragma unroll
            for (int s2 = 0; s2 < 4; ++s2) { const bf16x8 va = *(const bf16x8*)(B + RO_VT + (vt * 16 + fr) * 272 + s2 * 64 + fq * 16); ao = __builtin_amdgcn_mfma_f32_16x16x32_bf16(va, pb[s2], ao, 0, 0, 0); }
#pragma unroll
            for (int ks = 0; ks < 2; ++ks) {
                const bf16x8 s1 = *(const bf16x8*)(B + RO_SF + (vt * 16 + fr) * 144 + ks * 64 + fq * 16), s2v = *(const bf16x8*)(B + RO_SB + (vt * 16 + fr) * 144 + ks * 64 + fq * 16);
                af = __builtin_amdgcn_mfma_f32_16x16x32_bf16(s1, qb[ks], af, 0, 0, 0);
                ab = __builtin_amdgcn_mfma_f32_16x16x32_bf16(s2v, qb[ks], ab, 0, 0, 0);
            }
#pragma unroll
            for (int r = 0; r < 4; ++r) o[vt][r] = ao[r] + qdf * af[r] + qdb * ab[r];
        }
        float sm = 0.f;
#pragma unroll
        for (int vt = 0; vt < 4; ++vt)
#pragma unroll
            for (int r = 0; r < 4; ++r) sm += o[vt][r];
        sm += __shfl_xor(sm, 16); sm += __shfl_xor(sm, 32);
        const float mean = sm * (1.0f / 64.0f);
        float q = 0.f;
#pragma unroll
        for (int vt = 0; vt < 4; ++vt)
#pragma unroll
            for (int r = 0; r < 4; ++r) { o[vt][r] -= mean; q += o[vt][r] * o[vt][r]; }
        q += __shfl_xor(q, 16); q += __shfl_xor(q, 32);
        const float rstd = rsqrtf(q * (1.0f / 64.0f) + LN_EPS);
        const size_t row = (size_t)rc * 128 + i;
#pragma unroll
        for (int vt = 0; vt < 4; ++vt) {
            const int col = h * 64 + vt * 16 + fq * 4;
            const f32x4 gw = *(const f32x4*)(p.gn_w + l * 512 + col), gb = *(const f32x4*)(p.gn_b + l * 512 + col);
            const u32x2 gg = *(const u32x2*)(Gb + row * 512 + col);
            const float g0 = bflo(gg.x), g1 = bfhi(gg.x), g2 = bflo(gg.y), g3 = bfhi(gg.y);
            float y0 = o[vt][0] * rstd * gw[0] + gb[0], y1 = o[vt][1] * rstd * gw[1] + gb[1], y2 = o[vt][2] * rstd * gw[2] + gb[2], y3 = o[vt][3] * rstd * gw[3] + gb[3];
            y0 = bf2f(f2bf(y0)); y1 = bf2f(f2bf(y1)); y2 = bf2f(f2bf(y2)); y3 = bf2f(f2bf(y3));
            u32x2 w; w.x = cvt_pk_bf16(g0 * sigmoidf_(g0) * y0, g1 * sigmoidf_(g1) * y1); w.y = cvt_pk_bf16(g2 * sigmoidf_(g2) * y2, g3 * sigmoidf_(g3) * y3);
            *(u32x2*)(MIX + row * DM + col) = w;
        }
        if (nxt < nitems) RO_STORE(cur ^ 1);
        __syncthreads();
        cur ^= 1;
    }
#undef RO_LOAD
#undef RO_STORE
}

template <int K> __device__ __forceinline__ void conv_tap(float (&acc)[32], const float (&in)[62], const float wk) {
#pragma unroll
    for (int t = 0; t < 32; ++t) acc[t] += in[t + K] * wk;
}
template <int... Ks> __device__ __forceinline__ void conv_all(float (&acc)[32], const float (&in)[62], const float (&w)[31], std::integer_sequence<int, Ks...>) { (conv_tap<Ks>(acc, in, w[Ks]), ...); }
__device__ __forceinline__ void phase_conv(const Params& p, int l, int nitems, unsigned char* lds_g) {
    const int bid_ = launder_s(blockIdx.x);
    float* tile = (float*)lds_g;
    float* stat = tile + 32 * 512;
    const int tid = launder_tid(), wave = tid >> 6, lane = tid & 63;
    const bf16_t* U = (const bf16_t*)(p.ws + OFF_R + R_U);
    bf16_t* MIX = (bf16_t*)(p.ws + OFF_H);
    float w[31];
#pragma unroll
    for (int k = 0; k < 31; ++k) w[k] = p.conv_w[((size_t)l * 31 + k) * 512 + tid];
    const float cb = p.conv_b[l * 512 + tid], lw = p.cln_w[l * 512 + tid], lb = p.cln_b[l * 512 + tid];
    for (int item = bid_; item < nitems; item += gridDim.x) {
        const int t0 = item * 32;
        int lo, hi;
        if (t0 < NLAT) { lo = t0 & ~(SEQL - 1); hi = lo + SEQL; } else { lo = NLAT + ((t0 - NLAT) & ~255); hi = lo + 256; }
        float acc[32];
#pragma unroll
        for (int t = 0; t < 32; ++t) acc[t] = cb;
        float in[62];
#pragma unroll
        for (int r = 0; r < 62; ++r) {
            const int row = t0 - 15 + r;
            const int rowc = row < lo ? lo : (row >= hi ? hi - 1 : row);
            const float msk = (row >= lo && row < hi) ? 1.0f : 0.0f;
            in[r] = bf2f((unsigned)U[(size_t)rowc * 512 + tid]) * msk;
        }
        conv_all(acc, in, w, std::make_integer_sequence<int, 31>{});
#pragma unroll
        for (int t = 0; t < 32; ++t) tile[t * 512 + tid] = acc[t];
        __syncthreads();
#pragma unroll
        for (int tt = 0; tt < 4; ++tt) {
            const int t = wave * 4 + tt;
            float v[8]; float s = 0.f;
#pragma unroll
            for (int i = 0; i < 8; ++i) { v[i] = tile[t * 512 + lane + 64 * i]; s += v[i]; }
#pragma unroll
            for (int o = 32; o >= 1; o >>= 1) s += __shfl_xor(s, o);
            const float mean = s * (1.0f / 512.0f);
            float q = 0.f;
#pragma unroll
            for (int i = 0; i < 8; ++i) { const float d = v[i] - mean; q += d * d; }
#pragma unroll
            for (int o = 32; o >= 1; o >>= 1) q += __shfl_xor(q, o);
            if (lane == 0) { stat[2 * t] = mean; stat[2 * t + 1] = rsqrtf(q * (1.0f / 512.0f) + LN_EPS); }
        }
        __syncthreads();
#pragma unroll
        for (int t = 0; t < 32; ++t) {
            const float y = (acc[t] - stat[2 * t]) * stat[2 * t + 1] * lw + lb;
            MIX[(size_t)(t0 + t) * DM + 512 + tid] = (bf16_t)f2bf(y * sigmoidf_(y));
        }
        __syncthreads();
    }
}

#define XB_TMO      128
#define XB_XCNT(j)  (256  + 64 * (j))
#define XB_XSUB(j)  (1280 + 64 * (j))
#define XB_XGEN(j)  (2304 + 64 * (j))
#define XB_TOP      3328
#define XB_TOPGEN   3392
#define XB_SPIN_CAP (1u << 20)
__device__ __forceinline__ unsigned xb_ld(unsigned* p)              { return __hip_atomic_load(p, __ATOMIC_RELAXED, __HIP_MEMORY_SCOPE_AGENT); }
__device__ __forceinline__ unsigned xb_add(unsigned* p, unsigned v) { return __hip_atomic_fetch_add(p, v, __ATOMIC_RELAXED, __HIP_MEMORY_SCOPE_AGENT); }
__device__ __forceinline__ unsigned xb_xcc_id() { return (unsigned)__builtin_amdgcn_s_getreg((3 << 11) | 20) & 0xFu; }
#define XB_SPIN(cond, bar) do { unsigned _sp = 0; while (cond) { __builtin_amdgcn_s_sleep(1); \
    if ((++_sp & 255u) == 0u) { if (xb_ld(&(bar)[XB_TMO])) break; if (_sp > XB_SPIN_CAP) { atomicAdd(&(bar)[XB_TMO], 1u); break; } } } } while (0)
struct XcdBarrier { unsigned* bar; unsigned x; volatile LAS unsigned* st; };
__device__ __forceinline__ XcdBarrier xcd_barrier_post(unsigned* bar, volatile LAS unsigned* st) {
    XcdBarrier b; b.bar = bar; b.x = xb_xcc_id(); b.st = st;
    if (threadIdx.x == 0) (void)xb_add(&bar[XB_XCNT(b.x)], 1u);
    return b;
}
__device__ __forceinline__ void xcd_barrier_complete(unsigned* bar, unsigned x, unsigned& nloc, unsigned& nx) {
    const unsigned G = gridDim.x * gridDim.y * gridDim.z;
    unsigned sum, cnt, mine, sp = 0u;
    for (;;) {
        sum = 0u; cnt = 0u; mine = 0u;
#pragma unroll
        for (unsigned j = 0; j < 16; ++j) { const unsigned c = xb_ld(&bar[XB_XCNT(j)]); sum += c; cnt += (c > 0u) ? 1u : 0u; mine = (j == x) ? c : mine; }
        if (sum == G) break;
        __builtin_amdgcn_s_sleep(1);
        if ((++sp & 255u) == 0u) { if (xb_ld(&bar[XB_TMO])) break; if (sp > XB_SPIN_CAP) { atomicAdd(&bar[XB_TMO], 1u); break; } }
    }
    nloc = mine > 0u ? mine : 1u; nx = cnt > 0u ? cnt : 1u;
}
__device__ __forceinline__ void xcd_barrier(const XcdBarrier& b) {
    asm volatile("s_waitcnt vmcnt(0)" ::: "memory");
    __syncthreads();
    if (threadIdx.x == 0) {
        unsigned* bar = b.bar;
        __builtin_amdgcn_s_waitcnt(0);
        unsigned nloc = b.st[0], nx = b.st[1];
        if (nloc == 0u) { xcd_barrier_complete(bar, b.x, nloc, nx); b.st[0] = nloc; b.st[1] = nx; }
        const unsigned old = xb_add(&bar[XB_XSUB(b.x)], 1u);
        const unsigned gen = old / nloc;
        if (old + 1u == (gen + 1u) * nloc) {
            __builtin_amdgcn_fence(__ATOMIC_RELEASE, "agent");
            asm volatile("s_waitcnt vmcnt(0)" ::: "memory");
            const unsigned og = xb_add(&bar[XB_TOP], 1u);
            const unsigned tg = og / nx;
            if (og + 1u == (tg + 1u) * nx) xb_add(&bar[XB_TOPGEN], 1u);
            else XB_SPIN(xb_ld(&bar[XB_TOPGEN]) == tg, bar);
            __builtin_amdgcn_fence(__ATOMIC_ACQUIRE, "agent");
            xb_add(&bar[XB_XGEN(b.x)], 1u);
            asm volatile("s_waitcnt vmcnt(0)" ::: "memory");
        } else {
            XB_SPIN(xb_ld(&bar[XB_XGEN(b.x)]) == gen, bar);
            __builtin_amdgcn_fence(__ATOMIC_ACQUIRE, "agent");
            asm volatile("s_waitcnt vmcnt(0)" ::: "memory");
        }
    }
    __syncthreads();
}

#ifndef REP_G
#define REP_G 1
#endif
#ifndef REP_N
#define REP_N 1
#endif
#ifndef REP_A
#define REP_A 1
#endif
#ifndef REP_B
#define REP_B 1
#endif
#ifndef REP_C
#define REP_C 1
#endif
#ifndef REP_D
#define REP_D 1
#endif
#ifndef REP_S
#define REP_S 1
#endif
#define GSYNC() do { for (int r_ = 0; r_ < REP_S; ++r_) xcd_barrier(xbar); } while (0)
__global__ void __launch_bounds__(512, 2) fwd_megakernel(Params p) {
    extern __shared__ __attribute__((aligned(16))) unsigned char lds[];
    cg::grid_group grid = cg::this_grid();
    LAS unsigned char* ldsl = (LAS unsigned char*)lds;
    const int G = gridDim.x;
    if (threadIdx.x < 16) ((volatile LAS unsigned*)(ldsl + LDS_CTL))[threadIdx.x] = 0u;
    __syncthreads();
    const XcdBarrier xbar = xcd_barrier_post((unsigned*)(p.ws + OFF_CTL), (volatile LAS unsigned*)(ldsl + LDS_CTL));
    float* X = (float*)(p.ws + OFF_X);
    bf16_t* H = (bf16_t*)(p.ws + OFF_H);
    const float* ADA = (const float*)(p.ws + OFF_ADA);
    bf16_t* WIN = (bf16_t*)(p.ws + OFF_WIN); bf16_t* WOUT = (bf16_t*)(p.ws + OFF_WOUT); bf16_t* WFF1 = (bf16_t*)(p.ws + OFF_WFF1); bf16_t* WFF2 = (bf16_t*)(p.ws + OFF_WFF2);
    bf16_t* U = (bf16_t*)(p.ws + OFF_R + R_U); bf16_t* HM = (bf16_t*)(p.ws + OFF_R);

    phase_adaln_rope(p, lds);
    convert_weights(p, 0, lds);
    grid.sync();
    row_pass(p, MTOT, nullptr, nullptr, ADA, 0, true, false);
    GSYNC();

    for (int l = 0; l < DEPTH; ++l) {
        const bool last = (l == DEPTH - 1);
        const int Ml = last ? NLAT : MTOT;
        const float* ada_l = ADA + (size_t)l * 3 * 6144;
        for (int r_ = 0; r_ < REP_G; ++r_) {
            pg8::Gemm g{H, WIN, MTOT, INW, DM}; pg8::StaticOrder S; S.init(MTOT, INW, G, launder_s(blockIdx.x));
            EpiInProj E{(bf16_t*)(p.ws + OFF_R), U, (const float*)(p.ws + OFF_ROPE), last ? 1 : 0};
            pg8::gemm_phase<EpiInProj>(ldsl, g, S, E);
        }
        GSYNC();
        for (int r_ = 0; r_ < REP_B; ++r_) phase_localkv(p, l);
        for (int r_ = 0; r_ < REP_C; ++r_) phase_conv(p, l, Ml / 32, lds);
        GSYNC();
        for (int r_ = 0; r_ < REP_D; ++r_) phase_scan(p, l);
        GSYNC();
        for (int r_ = 0; r_ < REP_A; ++r_) phase_retout(p, l, (Ml / 128) * 8, lds);
        GSYNC();
        {
            pg8::Gemm g{H, WOUT, Ml, DM, DM}; pg8::StaticOrder S; S.init(Ml, DM, G, launder_s(blockIdx.x));
            EpiRes E{X, ada_l + 2 * 1024};
            pg8::gemm_phase<EpiRes>(ldsl, g, S, E);
        }
        GSYNC();
        row_pass(p, Ml, p.ln1_w + l * DM, p.ln1_b + l * DM, ada_l, 3, false, false);
        GSYNC();
        for (int r_ = 0; r_ < REP_G; ++r_) {
            pg8::Gemm g{H, WFF1, Ml, DFF, DM}; pg8::StaticOrder S; S.init(Ml, DFF, G, launder_s(blockIdx.x));
            EpiFF1 E{HM};
            pg8::gemm_phase<EpiFF1>(ldsl, g, S, E);
        }
        GSYNC();
        {
            pg8::Gemm g{HM, WFF2, Ml, DM, DFF}; pg8::StaticOrder S; S.init(Ml, DM, G, launder_s(blockIdx.x));
            EpiRes E{X, ada_l + 5 * 1024};
            pg8::gemm_phase<EpiRes>(ldsl, g, S, E);
        }
        GSYNC();
        if (!last) {
            row_pass(p, MTOT, p.ln2_w + l * DM, p.ln2_b + l * DM, ada_l + 3 * 6144, 0, false, false);
            convert_weights(p, l + 1, lds);
            GSYNC();
        } else {
            row_pass(p, NLAT, p.ln2_w + l * DM, p.ln2_b + l * DM, ada_l, 0, false, true);
        }
    }
}

extern "C" void kernel_launch(void* const* d_in, const int* in_sizes, int n_in, void* d_out, int out_size, void* d_ws, size_t ws_size, hipStream_t stream) {
    static int grid_blocks = 0;
    if (grid_blocks == 0) {
        if (n_in != 22 || ws_size < WS_NEED) { fprintf(stderr, "kernel_launch: need 22 inputs and %zu bytes of workspace (got %d, %zu)\n", (size_t)WS_NEED, n_in, ws_size); grid_blocks = -1; return; }
        int dev = 0, cus = 0, per_cu = 0;
        hipGetDevice(&dev);
        hipDeviceGetAttribute(&cus, hipDeviceAttributeMultiprocessorCount, dev);
        hipFuncSetAttribute((const void*)fwd_megakernel, hipFuncAttributeMaxDynamicSharedMemorySize, LDS_BYTES);
        hipOccupancyMaxActiveBlocksPerMultiprocessor(&per_cu, (const void*)fwd_megakernel, 512, LDS_BYTES);
        if (per_cu < 1) { fprintf(stderr, "kernel_launch: occupancy query says %d blocks per CU\n", per_cu); per_cu = 1; }
        (void)hipGetLastError();
        grid_blocks = cus * 1;
    }
    if (grid_blocks < 0) return;
    if (hipMemsetAsync((char*)d_ws + OFF_CTL, 0, CTL_BYTES, stream) != hipSuccess) { fprintf(stderr, "kernel_launch: memset of barrier words failed\n"); return; }
    Params p{};
    const float** pp = (const float**)&p;
    for (int i = 0; i < 22; ++i) pp[i] = (const float*)d_in[i];
    p.out = (float*)d_out; p.ws = (unsigned char*)d_ws;
    void* args[] = {&p};
    hipError_t e = hipLaunchCooperativeKernel((const void*)fwd_megakernel, dim3(grid_blocks), dim3(512), args, LDS_BYTES, stream);
    if (e != hipSuccess) fprintf(stderr, "cooperative launch failed: %s (grid %d)\n", hipGetErrorString(e), grid_blocks);
}
```
